# Optimizing an MI355X kernel written in HIP

```python
import math
import jax, jax.numpy as jnp
from jax import lax
import numpy as np

D_MODEL = 4096
BATCH = 2
SEQ = 4096
DEPTH = 1

MEM_LEN = 256
SWA_HEADS = 16
SWA_KV_HEADS = 4
SWA_HEAD_DIM = 128
WINDOW = 128
BLOCK = 128
M_HEADS = 4
M_QK_DIM = 128
M_V_DIM = 256
M_CHUNK = 128
CONV_WIDTH = 4
X_HEADS = 4
X_HEAD_DIM = 256
NUM_BUCKETS = 32
MAX_DISTANCE = 128

SWA_W = SWA_HEADS * SWA_HEAD_DIM
SWA_KV_W = SWA_KV_HEADS * SWA_HEAD_DIM
M_QK_W = M_HEADS * M_QK_DIM
M_V_W = M_HEADS * M_V_DIM
X_W = X_HEADS * X_HEAD_DIM
MIX_W = SWA_W + M_V_W + X_W

IN_SPLITS = (
    SWA_W, SWA_KV_W, SWA_KV_W, SWA_W,
    M_QK_W, M_QK_W, M_V_W, M_HEADS, M_HEADS, M_V_W, M_V_W,
    X_W, X_W,
)
IN_W = sum(IN_SPLITS)

DEEPNORM_ALPHA = (2.0 * DEPTH) ** 0.25
DEEPNORM_BETA = (8.0 * DEPTH) ** -0.25
LN_EPS = 1e-5
HEAD_NORM_EPS = 1e-6

kernel_name = "hymba_swa_mlstm_memxattn_deepnorm"


def _split_points(sizes):
    pts, acc = [], 0
    for s in sizes[:-1]:
        acc += s
        pts.append(acc)
    return pts


def layer_norm(x, g, b):
    xf = x.astype(jnp.float32)
    mu = jnp.mean(xf, axis=-1, keepdims=True)
    var = jnp.mean(jnp.square(xf - mu), axis=-1, keepdims=True)
    return (xf - mu) * lax.rsqrt(var + LN_EPS) * g.astype(jnp.float32) + b.astype(jnp.float32)


def t5_bucket(dist):
    max_exact = NUM_BUCKETS // 2
    is_small = dist < max_exact
    ratio = jnp.maximum(dist, max_exact).astype(jnp.float32) / max_exact
    large = max_exact + (jnp.log(ratio) / math.log(MAX_DISTANCE / max_exact)
                         * (NUM_BUCKETS - max_exact)).astype(jnp.int32)
    large = jnp.minimum(large, NUM_BUCKETS - 1)
    return jnp.where(is_small, dist, large)


def causal_depthwise_conv(x, w, b):
    c = x.shape[-1]
    y = lax.conv_general_dilated(
        x, w[:, None, :].astype(x.dtype), window_strides=(1,),
        padding=((CONV_WIDTH - 1, 0),),
        dimension_numbers=("NWC", "WIO", "NWC"),
        feature_group_count=c)
    return y + b.astype(x.dtype)


def swa_attention(q, k, v, rel_bias, sinks):
    B, S = q.shape[0], q.shape[1]
    nb = S // BLOCK
    G = SWA_HEADS // SWA_KV_HEADS
    q = q.reshape(B, nb, BLOCK, SWA_KV_HEADS, G, SWA_HEAD_DIM)
    k = k.reshape(B, nb, BLOCK, SWA_KV_HEADS, SWA_HEAD_DIM)
    v = v.reshape(B, nb, BLOCK, SWA_KV_HEADS, SWA_HEAD_DIM)
    shift = lambda t: jnp.concatenate([jnp.zeros_like(t[:, :1]), t[:, :-1]], axis=1)
    kk = jnp.concatenate([shift(k), k], axis=2)
    vv = jnp.concatenate([shift(v), v], axis=2)
    s = jnp.einsum("bnqkgd,bnskd->bnkgqs", q, kk).astype(jnp.float32) * (SWA_HEAD_DIM ** -0.5)

    qi = jnp.arange(BLOCK, dtype=jnp.int32)[:, None]
    si = jnp.arange(2 * BLOCK, dtype=jnp.int32)[None, :]
    dist = qi + BLOCK - si
    in_win = (dist >= 0) & (dist < WINDOW)
    first = (jnp.arange(nb) == 0)[:, None, None]
    valid = in_win[None] & ~(first & (si < BLOCK)[None])

    bucket = t5_bucket(jnp.clip(dist, 0, MAX_DISTANCE - 1))
    bias = rel_bias[bucket].astype(jnp.float32)
    bias = bias.transpose(2, 0, 1).reshape(SWA_KV_HEADS, G, BLOCK, 2 * BLOCK)
    s = jnp.where(valid[None, :, None, None], s + bias, -jnp.inf)

    sink = sinks.astype(jnp.float32).reshape(SWA_KV_HEADS, G)[None, None, :, :, None, None]
    m = jnp.maximum(jnp.max(s, axis=-1, keepdims=True), sink)
    p = jnp.exp(s - m)
    denom = jnp.sum(p, axis=-1, keepdims=True) + jnp.exp(sink - m)
    o = jnp.einsum("bnkgqs,bnskd->bnqkgd", (p / denom).astype(vv.dtype), vv)
    return o.reshape(B, S, SWA_W)


def mlstm_chunkwise(q, k, v, i_pre, f_pre):
    B, S = q.shape[0], q.shape[1]
    nc, L = S // M_CHUNK, M_CHUNK
    to_chunks = lambda t: jnp.moveaxis(
        t.astype(jnp.float32).reshape((B, nc, L) + t.shape[2:]), 3, 1)
    q = to_chunks(q)
    k = to_chunks(k) * (M_QK_DIM ** -0.5)
    v = to_chunks(v)
    log_i = to_chunks(i_pre)
    log_f = jax.nn.log_sigmoid(to_chunks(f_pre))

    b = jnp.cumsum(log_f, axis=-1)
    g = b[..., -1]
    a = g[..., None] - b + log_i
    m_loc = jnp.max(a, axis=-1)
    w = jnp.exp(a - m_loc[..., None])
    C_loc = jnp.einsum("bhclv,bhcld->bhcvd", w[..., None] * v, k)
    n_loc = jnp.einsum("bhcl,bhcld->bhcd", w, k)

    def step(carry, xs):
        C, n, m = carry
        g_c, m_l, C_l, n_l = xs
        m_new = jnp.maximum(g_c + m, m_l)
        sp = jnp.exp(g_c + m - m_new)
        sl = jnp.exp(m_l - m_new)
        C_new = sp[..., None, None] * C + sl[..., None, None] * C_l
        n_new = sp[..., None] * n + sl[..., None] * n_l
        return (C_new, n_new, m_new), (C, n, m)

    init = (jnp.zeros((B, M_HEADS, M_V_DIM, M_QK_DIM), jnp.float32),
            jnp.zeros((B, M_HEADS, M_QK_DIM), jnp.float32),
            jnp.zeros((B, M_HEADS), jnp.float32))
    xs = (jnp.moveaxis(g, 2, 0), jnp.moveaxis(m_loc, 2, 0),
          jnp.moveaxis(C_loc, 2, 0), jnp.moveaxis(n_loc, 2, 0))
    _, (C_prev, n_prev, m_prev) = lax.scan(step, init, xs)
    C_prev = jnp.moveaxis(C_prev, 0, 2)
    n_prev = jnp.moveaxis(n_prev, 0, 2)
    m_prev = jnp.moveaxis(m_prev, 0, 2)

    causal = jnp.tril(jnp.ones((L, L), dtype=bool))
    D = b[..., :, None] - b[..., None, :] + log_i[..., None, :]
    D = jnp.where(causal, D, -jnp.inf)
    inter = b + m_prev[..., None]
    m_t = jnp.maximum(inter, jnp.max(D, axis=-1))
    Sm = jnp.einsum("bhctd,bhcsd->bhcts", q, k) * jnp.exp(D - m_t[..., None])
    w_inter = jnp.exp(inter - m_t)
    num = (jnp.einsum("bhcts,bhcsv->bhctv", Sm, v)
           + w_inter[..., None] * jnp.einsum("bhctd,bhcvd->bhctv", q, C_prev))
    den = jnp.sum(Sm, axis=-1) + w_inter * jnp.einsum("bhctd,bhcd->bhct", q, n_prev)
    h = num / jnp.maximum(jnp.abs(den), jnp.exp(-m_t))[..., None]
    return jnp.moveaxis(h, 1, 3).reshape(B, S, M_HEADS, M_V_DIM)


def setup_inputs(seed: int = 0) -> dict:
    key = jax.random.key(seed)
    ks = jax.random.split(key, 14)
    f32 = jnp.float32
    x = jax.random.normal(ks[0], (BATCH, SEQ, D_MODEL), f32)
    mem = jax.random.normal(ks[1], (BATCH, MEM_LEN, D_MODEL), f32)
    w_in = jax.random.normal(ks[2], (D_MODEL, IN_W), f32) * D_MODEL ** -0.5
    conv_w = jax.random.normal(ks[3], (CONV_WIDTH, 2 * M_QK_W), f32) * CONV_WIDTH ** -0.5
    conv_b = 0.01 * jax.random.normal(ks[4], (2 * M_QK_W,), f32)
    b_i = 0.1 * jax.random.normal(ks[5], (M_HEADS,), f32)
    b_f = 3.0 + 3.0 * jax.random.uniform(ks[6], (M_HEADS,), f32)
    m_norm_g = 1.0 + 0.02 * jax.random.normal(ks[7], (M_V_W,), f32)
    rel_bias = 0.1 * jax.random.normal(ks[8], (NUM_BUCKETS, SWA_HEADS), f32)
    sinks = jax.random.normal(ks[9], (SWA_HEADS,), f32)
    w_mem_kv = jax.random.normal(ks[10], (D_MODEL, 2 * X_W), f32) * D_MODEL ** -0.5
    w_out = jax.random.normal(ks[11], (MIX_W, D_MODEL), f32) * (MIX_W ** -0.5) * DEEPNORM_BETA
    ln_g = 1.0 + 0.02 * jax.random.normal(ks[12], (D_MODEL,), f32)
    ln_b = 0.02 * jax.random.normal(ks[13], (D_MODEL,), f32)
    return {"x": x, "mem": mem, "w_in": w_in, "conv_w": conv_w, "conv_b": conv_b,
            "b_i": b_i, "b_f": b_f, "m_norm_g": m_norm_g, "rel_bias": rel_bias,
            "sinks": sinks, "w_mem_kv": w_mem_kv, "w_out": w_out,
            "ln_g": ln_g, "ln_b": ln_b}


def reference(x, mem, w_in, conv_w, conv_b, b_i, b_f, m_norm_g, rel_bias, sinks,
              w_mem_kv, w_out, ln_g, ln_b):
    B, S, _ = x.shape
    for _layer in range(DEPTH):
        proj = jnp.einsum("bsd,de->bse", x, w_in)
        (a_q, a_k, a_v, a_z, m_q, m_k, m_v, m_i, m_f, m_o, m_z, c_q, c_z) = jnp.split(
            proj, _split_points(IN_SPLITS), axis=-1)

        a_out = swa_attention(
            a_q.reshape(B, S, SWA_HEADS, SWA_HEAD_DIM),
            a_k.reshape(B, S, SWA_KV_HEADS, SWA_HEAD_DIM),
            a_v.reshape(B, S, SWA_KV_HEADS, SWA_HEAD_DIM),
            rel_bias, sinks)
        a_out = a_out.astype(jnp.float32) * jax.nn.silu(a_z.astype(jnp.float32))

        qk = jax.nn.silu(causal_depthwise_conv(jnp.concatenate([m_q, m_k], axis=-1), conv_w, conv_b))
        mq, mk = jnp.split(qk, [M_QK_W], axis=-1)
        i_pre = m_i.astype(jnp.float32) + b_i.astype(jnp.float32)
        f_pre = m_f.astype(jnp.float32) + b_f.astype(jnp.float32)
        h = mlstm_chunkwise(
            mq.reshape(B, S, M_HEADS, M_QK_DIM), mk.reshape(B, S, M_HEADS, M_QK_DIM),
            m_v.reshape(B, S, M_HEADS, M_V_DIM), i_pre, f_pre)
        h = jax.nn.sigmoid(m_o.astype(jnp.float32)).reshape(B, S, M_HEADS, M_V_DIM) * h
        mu = jnp.mean(h, axis=-1, keepdims=True)
        var = jnp.mean(jnp.square(h - mu), axis=-1, keepdims=True)
        h = (h - mu) * lax.rsqrt(var + HEAD_NORM_EPS) * m_norm_g.astype(jnp.float32).reshape(M_HEADS, M_V_DIM)
        m_out = h.reshape(B, S, M_V_W) * jax.nn.silu(m_z.astype(jnp.float32))

        mkv = jnp.einsum("bmd,de->bme", mem, w_mem_kv)
        mem_k, mem_v = jnp.split(mkv, [X_W], axis=-1)
        mem_k = mem_k.reshape(B, MEM_LEN, X_HEADS, X_HEAD_DIM)
        mem_v = mem_v.reshape(B, MEM_LEN, X_HEADS, X_HEAD_DIM)
        cs = jnp.einsum("bqhd,bmhd->bhqm", c_q.reshape(B, S, X_HEADS, X_HEAD_DIM),
                        mem_k).astype(jnp.float32) * (X_HEAD_DIM ** -0.5)
        cp = jax.nn.softmax(cs, axis=-1)
        c_out = jnp.einsum("bhqm,bmhd->bqhd", cp.astype(mem_v.dtype), mem_v).reshape(B, S, X_W)
        c_out = c_out.astype(jnp.float32) * jax.nn.silu(c_z.astype(jnp.float32))

        mix = jnp.concatenate([a_out, m_out, c_out], axis=-1).astype(x.dtype)
        y = jnp.einsum("bse,ed->bsd", mix, w_out)
        x = layer_norm(DEEPNORM_ALPHA * x.astype(jnp.float32) + y.astype(jnp.float32),
                       ln_g, ln_b).astype(x.dtype)
    return x
```

```cpp
#include <hip/hip_runtime.h>
#include <cstdio>
#include <cstdint>
#include <cstddef>
namespace pg8 {
#define PG8_LAS __attribute__((address_space(3)))
typedef unsigned short bf16_t;
typedef short bf16x8 __attribute__((ext_vector_type(8)));
typedef float f32x4 __attribute__((ext_vector_type(4)));
typedef unsigned u32x4 __attribute__((ext_vector_type(4)));
constexpr int BM = 256, BK = 64, HALF = 128, HTB = HALF * BK * 2  , STAGE_BYTES = 8 * HTB, NXCD = 8, WGM = 8;

__host__ __device__ __forceinline__ int lds_byte(int r, int c) { const int st = (r >> 4) * 2 + (c >> 5), rr = r & 15, cc = c & 31, ob = rr * 64 + cc * 2; return st * 1024 + (ob ^ (((ob >> 9) & 1) << 5)); }
__host__ __device__ __forceinline__ void stage_rc(int b, int& R, int& C) { const int st = b / 1024, sb = b % 1024, swz = sb ^ (((sb >> 9) & 1) << 5); R = (st >> 1) * 16 + swz / 64; C = (st & 1) * 32 + (swz % 64) / 2; }
__host__ __device__ __forceinline__ int perm32(int rho) { const int n = rho >> 4, i = rho & 15; return 8 * (i >> 2) + 4 * n + (i & 3); }

struct Unit { int pm, pn; };
struct Gemm { const bf16_t* A; const bf16_t* Bt; int M, N, K; };

struct StaticOrder {
    int nM, nN, nwg, G, c;
    __host__ __device__ void init(int M, int N, int G_, int c_) { nM = M / BM; nN = N / BM; nwg = nM * nN; G = G_; c = c_; }
    __host__ __device__ bool next(int i, Unit& u) const {
        const long L = (long)i * G + c; if (L >= nwg) return false;
        int wgid = (int)L; { const int q = nwg / NXCD, r = nwg % NXCD, xcd = wgid % NXCD, off = wgid / NXCD; wgid = (xcd < r ? xcd * (q + 1) : r * (q + 1) + (xcd - r) * q) + off; }
        const int nig = WGM * nN, gid = wgid / nig, fm = gid * WGM, gsz = (nM - fm) < WGM ? (nM - fm) : WGM;
        u.pm = fm + ((wgid % nig) % gsz); u.pn = (wgid % nig) / gsz; return true;
    }
    __device__ __forceinline__ void a_ready(const Unit&) const {}
    __device__ __forceinline__ void done(const Unit&) const {}
};
__device__ __forceinline__ unsigned cvt_pk_bf16(float lo, float hi) { unsigned r; asm volatile("v_cvt_pk_bf16_f32 %0, %1, %2" : "=v"(r) : "v"(lo), "v"(hi)); return r; }
typedef float f32x2 __attribute__((ext_vector_type(2)));
__device__ __forceinline__ float sigmoid_f(float v) { return __builtin_amdgcn_rcpf(1.0f + __builtin_amdgcn_exp2f(-1.4426950408889634f * v)); }
struct EpiProj {
    static constexpr bool PERM = true, AFTER_DRAIN = false;
    bf16_t* P; int ldp; bf16_t* MKV; int ldm;
    __device__ __forceinline__ void operator()(const f32x4 (&acc)[2][2][4][2], const Unit& u, int wr, int wc, int fr, int fq) const {
        bf16_t* base; int ld; int act = 0;
        if (u.pm < 32) { base = P + (size_t)(u.pm * BM) * ldp + u.pn * BM; ld = ldp; const int pn = u.pn;
            act = ((pn >= 12 && pn < 20) || (pn >= 32 && pn < 36) || pn >= 40) ? 1 : ((pn >= 28 && pn < 32) ? 2 : 0); }
        else { base = MKV + (size_t)((u.pm - 32) * BM) * ldm + (u.pn - 44) * BM; ld = ldm; }
        const int row0 = wr * 64 + fr, col0 = wc * 32 + 8 * fq;
#pragma unroll
        for (int ai = 0; ai < 2; ++ai)
#pragma unroll
            for (int m = 0; m < 4; ++m) { bf16_t* rowp = base + (size_t)(row0 + ai * HALF + m * 16) * ld + col0;
#pragma unroll
                for (int bj = 0; bj < 2; ++bj) { f32x4 v0 = acc[ai][bj][m][0], v1 = acc[ai][bj][m][1];
                    if (act == 1) {
#pragma unroll
                        for (int j = 0; j < 4; ++j) { v0[j] = v0[j] * sigmoid_f(v0[j]); v1[j] = v1[j] * sigmoid_f(v1[j]); } }
                    else if (act == 2) {
#pragma unroll
                        for (int j = 0; j < 4; ++j) { v0[j] = sigmoid_f(v0[j]); v1[j] = sigmoid_f(v1[j]); } }
                    u32x4 w; w.x = cvt_pk_bf16(v0[0], v0[1]); w.y = cvt_pk_bf16(v0[2], v0[3]); w.z = cvt_pk_bf16(v1[0], v1[1]); w.w = cvt_pk_bf16(v1[2], v1[3]);
                    *(u32x4*)(rowp + bj * HALF) = w; } }
    }
};
struct EpiY {
    static constexpr bool PERM = true, AFTER_DRAIN = false;
    bf16_t* O; int ldc;
    __device__ __forceinline__ void operator()(const f32x4 (&acc)[2][2][4][2], const Unit& u, int wr, int wc, int fr, int fq) const {
        bf16_t* base = O + (size_t)(u.pm * BM) * ldc + u.pn * BM;
        const int row0 = wr * 64 + fr, col0 = wc * 32 + 8 * fq;
#pragma unroll
        for (int ai = 0; ai < 2; ++ai)
#pragma unroll
            for (int m = 0; m < 4; ++m) { bf16_t* rowp = base + (size_t)(row0 + ai * HALF + m * 16) * ldc + col0;
#pragma unroll
                for (int bj = 0; bj < 2; ++bj) { const f32x4 v0 = acc[ai][bj][m][0], v1 = acc[ai][bj][m][1];
                    u32x4 w; w.x = cvt_pk_bf16(v0[0], v0[1]); w.y = cvt_pk_bf16(v0[2], v0[3]); w.z = cvt_pk_bf16(v1[0], v1[1]); w.w = cvt_pk_bf16(v1[2], v1[3]);
                    *(u32x4*)(rowp + bj * HALF) = w; } }
    }
};
struct InProjOrder {
    int G, c;
    __device__ __forceinline__ bool next(int i, Unit& u) const {
        const int L = i * G + c; if (L >= 1424) return false;
        if (L >= 1408) { const int j = L - 1408; u.pm = 32 + (j >> 3); u.pn = 44 + (j & 7); return true; }
        const int xcd = L % NXCD, off = L / NXCD, wgid = xcd * 176 + off;
        const int nig = WGM * 44, gid = wgid / nig, fm = gid * WGM;
        u.pm = fm + ((wgid % nig) % WGM); u.pn = (wgid % nig) / WGM; return true;
    }
    __device__ __forceinline__ void a_ready(const Unit&) const {}
    __device__ __forceinline__ void done(const Unit&) const {}
};
template <class Epi, class Sched, bool ALIGN_EPI = false, bool SP2 = false>
__device__ __forceinline__ void gemm_phase(PG8_LAS unsigned char* lds, const Gemm g, const Sched& S, const Epi& E) {
    const int tid = threadIdx.x, wid = __builtin_amdgcn_readfirstlane(tid >> 6), lane = tid & 63, wr = wid >> 2, wc = wid & 3, fr = lane & 15, fq = lane >> 4;
    const int K = g.K, nt = K / BK;
    unsigned voffA[2], voffB[2];
#pragma unroll
    for (int i = 0; i < 2; ++i) { int R, C; stage_rc(tid * 16 + i * 8192, R, C); const int Rb = Epi::PERM ? ((R & ~31) + perm32(R & 31)) : R;
        voffA[i] = (unsigned)(R * K + C) * 2u; voffB[i] = (unsigned)(Rb * K + C) * 2u; }
    const size_t kstep = (size_t)(BK * 2);
    const size_t hstep = (size_t)HALF * K * 2;
    const size_t tstep = 2 * hstep;
    const unsigned ldsw = (unsigned)wid * 1024u;
    const int aoff = lds_byte(wr * 64 + fr, fq * 8), boff = lds_byte(wc * 32 + fr, fq * 8);
#define PG8_SA(b, h) (((b) * 2 + (h)) * HTB)
#define PG8_SB(b, h) ((4 + (b) * 2 + (h)) * HTB)
#define PG8_STAGE(bufoff, gbase, voff) do { _Pragma("unroll") for (int _i = 0; _i < 2; ++_i) \
        __builtin_amdgcn_global_load_lds((const unsigned*)((const char*)(gbase) + (voff)[_i]), (PG8_LAS unsigned*)(lds + (bufoff) + ldsw + _i * 8192), 16, 0, 0); } while (0)
#define PG8_LDA(dst, b, h) do { _Pragma("unroll") for (int m = 0; m < 4; ++m) _Pragma("unroll") for (int k = 0; k < 2; ++k) dst[m][k] = *(const PG8_LAS bf16x8*)(lds + PG8_SA(b, h) + aoff + m * 2048 + k * 1024); } while (0)
#define PG8_LDB(dst, b, h) do { _Pragma("unroll") for (int n = 0; n < 2; ++n) _Pragma("unroll") for (int k = 0; k < 2; ++k) dst[n][k] = *(const PG8_LAS bf16x8*)(lds + PG8_SB(b, h) + boff + n * 2048 + k * 1024); } while (0)
#define PG8_MMA(ai, bj, At, Bt) do { __builtin_amdgcn_s_setprio(1); _Pragma("unroll") for (int m = 0; m < 4; ++m) _Pragma("unroll") for (int n = 0; n < 2; ++n) _Pragma("unroll") for (int k = 0; k < 2; ++k) \
        acc[ai][bj][m][n] = __builtin_amdgcn_mfma_f32_16x16x32_bf16(Bt[n][k], At[m][k], acc[ai][bj][m][n], 0, 0, 0); __builtin_amdgcn_s_setprio(0); } while (0)
#define PG8_WAIT_V(n) asm volatile("s_waitcnt vmcnt(" #n ")" ::: "memory")
#define PG8_WAIT_L(n) asm volatile("s_waitcnt lgkmcnt(" #n ")" ::: "memory")
#define PG8_BAR __builtin_amdgcn_s_barrier()
#define PG8_SCHED __builtin_amdgcn_sched_barrier(0)
    Unit cur, nxt; int ui = 0;
    if (!S.next(0, cur)) return;
    f32x4 acc[2][2][4][2];
#pragma unroll
    for (int a = 0; a < 2; ++a)
#pragma unroll
        for (int b = 0; b < 2; ++b)
#pragma unroll
            for (int m = 0; m < 4; ++m)
#pragma unroll
                for (int n = 0; n < 2; ++n) acc[a][b][m][n] = (f32x4){0.f, 0.f, 0.f, 0.f};
    bf16x8 At[4][2], B0[2][2], B1[2][2];
    const char* cA = (const char*)g.A + (size_t)cur.pm * tstep; const char* cB = (const char*)g.Bt + (size_t)cur.pn * tstep;
    S.a_ready(cur);
    if constexpr (SP2) {
        PG8_STAGE(PG8_SB(0, 0), cB, voffB); PG8_STAGE(PG8_SB(0, 1), cB + hstep, voffB); PG8_STAGE(PG8_SA(0, 0), cA, voffA); PG8_STAGE(PG8_SA(0, 1), cA + hstep, voffA);
        if (wr == 1) PG8_BAR;
        PG8_WAIT_V(2); PG8_BAR;
        PG8_STAGE(PG8_SB(1, 0), cB + kstep, voffB); PG8_STAGE(PG8_SA(1, 0), cA + kstep, voffA); PG8_STAGE(PG8_SB(1, 1), cB + hstep + kstep, voffB);
        PG8_WAIT_V(6); PG8_BAR;
    } else {
        PG8_STAGE(PG8_SB(0, 0), cB, voffB); PG8_STAGE(PG8_SA(0, 0), cA, voffA); PG8_STAGE(PG8_SB(0, 1), cB + hstep, voffB); PG8_STAGE(PG8_SA(0, 1), cA + hstep, voffA);
        if (wr == 1) PG8_BAR;
        PG8_WAIT_V(4); PG8_BAR;
        PG8_STAGE(PG8_SB(1, 0), cB + kstep, voffB); PG8_STAGE(PG8_SA(1, 0), cA + kstep, voffA); PG8_STAGE(PG8_SB(1, 1), cB + hstep + kstep, voffB);
        PG8_WAIT_V(6); PG8_BAR;
    }
    for (;;) {
        const bool has_next = S.next(ui + 1, nxt);
        const char* nA = has_next ? (const char*)g.A + (size_t)nxt.pm * tstep : cA; const char* nB = has_next ? (const char*)g.Bt + (size_t)nxt.pn * tstep : cB;
        for (int t = 0; t < nt; t += 2) {
            const bool last = (t == nt - 2);
            const char* a1 = cA + (size_t)(t + 1) * kstep;
            const char* a2 = last ? nA : cA + (size_t)(t + 2) * kstep; const char* b2 = last ? nB : cB + (size_t)(t + 2) * kstep;
            const char* a3 = a2 + kstep; const char* b3 = b2 + kstep;
            if (last && has_next) S.a_ready(nxt);
            if constexpr (SP2) {
            PG8_LDB(B0, 0, 0); PG8_LDB(B1, 0, 1); PG8_SCHED; PG8_LDA(At, 0, 0); PG8_STAGE(PG8_SA(1, 1), a1 + hstep, voffA);
            PG8_WAIT_V(8); PG8_WAIT_L(0); PG8_BAR; PG8_MMA(0, 0, At, B0); PG8_MMA(0, 1, At, B1); PG8_BAR; PG8_SCHED;
            PG8_LDA(At, 0, 1); PG8_STAGE(PG8_SB(0, 0), b2, voffB); PG8_STAGE(PG8_SB(0, 1), b2 + hstep, voffB); PG8_STAGE(PG8_SA(0, 0), a2, voffA);
            PG8_WAIT_V(8); PG8_WAIT_L(0); PG8_BAR; PG8_MMA(1, 0, At, B0); PG8_MMA(1, 1, At, B1); PG8_BAR; PG8_SCHED;
            PG8_LDB(B0, 1, 0); PG8_LDB(B1, 1, 1); PG8_SCHED; PG8_LDA(At, 1, 0); PG8_STAGE(PG8_SA(0, 1), a2 + hstep, voffA);
            PG8_WAIT_V(8); PG8_WAIT_L(0); PG8_BAR; PG8_MMA(0, 0, At, B0); PG8_MMA(0, 1, At, B1); PG8_BAR; PG8_SCHED;
            PG8_LDA(At, 1, 1); PG8_STAGE(PG8_SB(1, 0), b3, voffB); PG8_STAGE(PG8_SB(1, 1), b3 + hstep, voffB); PG8_STAGE(PG8_SA(1, 0), a3, voffA);
            PG8_WAIT_V(8); PG8_WAIT_L(0); PG8_BAR; PG8_MMA(1, 0, At, B0); PG8_MMA(1, 1, At, B1); PG8_BAR; PG8_SCHED;
            } else {
            PG8_LDB(B0, 0, 0); PG8_SCHED; PG8_LDA(At, 0, 0); PG8_STAGE(PG8_SA(1, 1), a1 + hstep, voffA);
            PG8_WAIT_L(8); PG8_BAR; PG8_WAIT_L(0); PG8_MMA(0, 0, At, B0); PG8_BAR; PG8_SCHED;
            PG8_LDB(B1, 0, 1); PG8_STAGE(PG8_SB(0, 0), b2, voffB);
            PG8_BAR; PG8_WAIT_L(0); PG8_MMA(0, 1, At, B1); PG8_BAR;
            PG8_LDA(At, 0, 1); PG8_STAGE(PG8_SA(0, 0), a2, voffA);
            PG8_BAR; PG8_WAIT_L(0); PG8_MMA(1, 0, At, B0); PG8_BAR; PG8_SCHED;
            PG8_STAGE(PG8_SB(0, 1), b2 + hstep, voffB);
            PG8_WAIT_V(6); PG8_BAR; PG8_MMA(1, 1, At, B1); PG8_BAR;
            PG8_LDB(B0, 1, 0); PG8_SCHED; PG8_LDA(At, 1, 0); PG8_STAGE(PG8_SA(0, 1), a2 + hstep, voffA);
            PG8_WAIT_L(8); PG8_BAR; PG8_WAIT_L(0); PG8_MMA(0, 0, At, B0); PG8_BAR; PG8_SCHED;
            PG8_LDB(B1, 1, 1); PG8_STAGE(PG8_SB(1, 0), b3, voffB);
            PG8_BAR; PG8_WAIT_L(0); PG8_MMA(0, 1, At, B1); PG8_BAR;
            PG8_LDA(At, 1, 1); PG8_STAGE(PG8_SA(1, 0), a3, voffA);
            PG8_BAR; PG8_WAIT_L(0); PG8_MMA(1, 0, At, B0); PG8_BAR; PG8_SCHED;
            PG8_STAGE(PG8_SB(1, 1), b3 + hstep, voffB);
            PG8_WAIT_V(6); PG8_BAR; PG8_MMA(1, 1, At, B1); PG8_BAR;
            }
        }
        if constexpr (ALIGN_EPI) { if (wr == 0) PG8_BAR; }
        if constexpr (!Epi::AFTER_DRAIN) { E(acc, cur, wr, wc, fr, fq); S.done(cur); }
        if (!has_next) break;
#pragma unroll
        for (int a = 0; a < 2; ++a)
#pragma unroll
            for (int b = 0; b < 2; ++b)
#pragma unroll
                for (int m = 0; m < 4; ++m)
#pragma unroll
                    for (int n = 0; n < 2; ++n) acc[a][b][m][n] = (f32x4){0.f, 0.f, 0.f, 0.f};
        cur = nxt; cA = nA; cB = nB; ++ui;
        if constexpr (ALIGN_EPI) { if (wr == 1) PG8_BAR; }
    }
    PG8_WAIT_V(0);
    if constexpr (!ALIGN_EPI) { if (wr == 0) PG8_BAR; }
    PG8_BAR;
    if constexpr (Epi::AFTER_DRAIN) { E.fused(acc, cur, wr, wc, fr, fq, lds, wid, lane); S.done(cur); }
#undef PG8_SA
#undef PG8_SB
#undef PG8_STAGE
#undef PG8_LDA
#undef PG8_LDB
#undef PG8_MMA
#undef PG8_WAIT_V
#undef PG8_WAIT_L
#undef PG8_BAR
#undef PG8_SCHED
}
}
#define GAS __attribute__((address_space(1)))
#define LAS __attribute__((address_space(3)))
typedef unsigned short bf16;
typedef unsigned v4u __attribute__((ext_vector_type(4)));
typedef float f32x4 __attribute__((ext_vector_type(4)));
typedef short bf16x8 __attribute__((ext_vector_type(8)));
typedef GAS unsigned gu32;
typedef GAS unsigned long long gu64;
#define RLX_AGENT __ATOMIC_RELAXED, __HIP_MEMORY_SCOPE_AGENT
#define LDS_WAIT() asm volatile("s_waitcnt lgkmcnt(0)" ::: "memory")
#define VM_WAIT() asm volatile("s_waitcnt vmcnt(0)" ::: "memory")
__device__ __forceinline__ unsigned long long rt() { return __builtin_amdgcn_s_memrealtime(); }
__device__ __forceinline__ unsigned f2bf(float f) { unsigned u = __builtin_bit_cast(unsigned, f); return (u + 0x7fffu + ((u >> 16) & 1u)) >> 16; }
__device__ __forceinline__ unsigned pk2(float lo, float hi) { return f2bf(lo) | (f2bf(hi) << 16); }

#define XB_TMO      128
#define XB_XCNT(j)  (256  + 64 * (j))
#define XB_XSUB(j)  (1280 + 64 * (j))
#define XB_XGEN(j)  (2304 + 64 * (j))
#define XB_TOP      3328
#define XB_TOPGEN   3392
#define XCD_BAR_WORDS 3456
#define XB_SPIN_CAP (1u << 18)

__device__ __forceinline__ unsigned xb_ld(unsigned* p)              { return __hip_atomic_load(p, __ATOMIC_RELAXED, __HIP_MEMORY_SCOPE_AGENT); }
__device__ __forceinline__ unsigned xb_add(unsigned* p, unsigned v) { return __hip_atomic_fetch_add(p, v, __ATOMIC_RELAXED, __HIP_MEMORY_SCOPE_AGENT); }
__device__ __forceinline__ unsigned xb_xcc_id() { return (unsigned)__builtin_amdgcn_s_getreg((3 << 11) | 20) & 0xFu; }
#define XB_SPIN(cond, bar) do { unsigned _sp = 0; while (cond) { __builtin_amdgcn_s_sleep(1); \
    if ((++_sp & 255u) == 0u) { if (xb_ld(&(bar)[XB_TMO])) break; if (_sp > XB_SPIN_CAP) { atomicAdd(&(bar)[XB_TMO], 1u); break; } } } } while (0)

struct XcdBarrier {
    unsigned* bar; unsigned x;
    volatile LAS unsigned* st;
};

__device__ __forceinline__ XcdBarrier xcd_barrier_post(unsigned* bar, volatile LAS unsigned* st) {
    XcdBarrier b; b.bar = bar; b.x = xb_xcc_id(); b.st = st;
    if (threadIdx.x == 0) (void)xb_add(&bar[XB_XCNT(b.x)], 1u);
    return b;
}
__device__ __forceinline__ void xcd_barrier_complete(unsigned* bar, unsigned x, unsigned& nloc, unsigned& nx) {
    const unsigned G = gridDim.x * gridDim.y * gridDim.z;
    unsigned sum, cnt, mine, sp = 0u;
    for (;;) {
        sum = 0u; cnt = 0u; mine = 0u;
#pragma unroll
        for (unsigned j = 0; j < 16; ++j) { const unsigned c = xb_ld(&bar[XB_XCNT(j)]); sum += c; cnt += (c > 0u) ? 1u : 0u; mine = (j == x) ? c : mine; }
        if (sum == G) break;
        __builtin_amdgcn_s_sleep(1);
        if ((++sp & 255u) == 0u) { if (xb_ld(&bar[XB_TMO])) break; if (sp > XB_SPIN_CAP) { atomicAdd(&bar[XB_TMO], 1u); break; } }
    }
    nloc = mine > 0u ? mine : 1u; nx = cnt > 0u ? cnt : 1u;
}

__device__ __forceinline__ void xcd_barrier(const XcdBarrier& b) {
    asm volatile("s_waitcnt vmcnt(0)" ::: "memory");
    __syncthreads();
    if (threadIdx.x == 0) {
        unsigned* bar = b.bar;
        __builtin_amdgcn_s_waitcnt(0);
        unsigned nloc = b.st[0], nx = b.st[1];
        if (nloc == 0u) { xcd_barrier_complete(bar, b.x, nloc, nx); b.st[0] = nloc; b.st[1] = nx; }
        const unsigned old = xb_add(&bar[XB_XSUB(b.x)], 1u);
        const unsigned gen = old / nloc;
        if (old + 1u == (gen + 1u) * nloc) {
            __builtin_amdgcn_fence(__ATOMIC_RELEASE, "agent");
            asm volatile("s_waitcnt vmcnt(0)" ::: "memory");
            const unsigned og = xb_add(&bar[XB_TOP], 1u);
            const unsigned tg = og / nx;
            if (og + 1u == (tg + 1u) * nx) xb_add(&bar[XB_TOPGEN], 1u);
            else XB_SPIN(xb_ld(&bar[XB_TOPGEN]) == tg, bar);
            __builtin_amdgcn_fence(__ATOMIC_ACQUIRE, "agent");
            xb_add(&bar[XB_XGEN(b.x)], 1u);
            asm volatile("s_waitcnt vmcnt(0)" ::: "memory");
        } else {
            XB_SPIN(xb_ld(&bar[XB_XGEN(b.x)]) == gen, bar);
            __builtin_amdgcn_fence(__ATOMIC_ACQUIRE, "agent");
            asm volatile("s_waitcnt vmcnt(0)" ::: "memory");
        }
    }
    __syncthreads();
}
constexpr int NWAVES = 8;
constexpr int DM = 4096, SEQ = 4096, MROWS = 8192, MEMROWS = 512;
constexpr int INW = 11272;
constexpr int NPROJ = 11264;
constexpr int C_AQ = 0, C_AK = 2048, C_AV = 2560, C_AZ = 3072, C_MQ = 5120, C_MK = 5632, C_MV = 6144, C_MO = 7168, C_MZ = 8192, C_CQ = 9216, C_CZ = 10240;
constexpr float LN_EPS = 1e-5f, HEAD_NORM_EPS = 1e-6f;
constexpr float DEEPNORM_ALPHA = 1.189207115002721f;

constexpr size_t MiB = 1u << 20;
constexpr size_t WS_CTL = 0, CTL_ZERO_BYTES = 1 * MiB;
constexpr size_t WS_ACAT = 2 * MiB;
constexpr size_t WS_BTCAT = 70 * MiB;
constexpr size_t WS_WOT = 174 * MiB;
constexpr size_t WS_PROJ = 206 * MiB;
constexpr size_t WS_MKV = 382 * MiB;
constexpr size_t WS_GATES = 384 * MiB;
constexpr size_t WS_MQK = 385 * MiB;
constexpr size_t WS_CLOC = 401 * MiB;
constexpr size_t WS_CPREV = 435 * MiB;
constexpr size_t WS_SMALL = 452 * MiB;
constexpr size_t WS_MIX = 453 * MiB;
constexpr size_t WS_Y = 517 * MiB;
constexpr size_t WS_END = 581 * MiB;
constexpr int CW_BAR = 4096;

constexpr int LDS_BYTES = 163840;
constexpr int MISC_OFF = LDS_BYTES - 256;

typedef unsigned v2u __attribute__((ext_vector_type(2)));
#define CAS __attribute__((address_space(4)))
struct Frame {
    LAS unsigned char* lds;
    volatile LAS unsigned* MISC;
    gu32* ctl;
    unsigned char* ws;
    const CAS unsigned char* kargs;
    int tid, lane, wave, G, vcu;
};
__device__ __forceinline__ const float* in_ptr(const Frame& F, int i) { const CAS unsigned char* p = F.kargs; asm volatile("" : "+s"(p)); return *(const float* const CAS*)(p + 8 * i); }
__device__ __forceinline__ float* out_ptr(const Frame& F) { const CAS unsigned char* p = F.kargs; asm volatile("" : "+s"(p)); return *(float* const CAS*)(p + 8 * 14); }
#define WSP(T, off) ((T*)(F.ws + (off)))
__device__ __forceinline__ float bf2f(unsigned h) { return __builtin_bit_cast(float, h << 16); }
__device__ __forceinline__ float wave_sum(float v) {
#pragma unroll
    for (int o = 1; o < 64; o <<= 1) v += __shfl_xor(v, o);
    return v;
}
__device__ __forceinline__ float quad_max(float v) { v = fmaxf(v, __shfl_xor(v, 16)); v = fmaxf(v, __shfl_xor(v, 32)); return v; }
__device__ __forceinline__ float quad_sum(float v) { v += __shfl_xor(v, 16); v += __shfl_xor(v, 32); return v; }
__device__ __forceinline__ float row16_sum(float v) { v += __shfl_xor(v, 1); v += __shfl_xor(v, 2); v += __shfl_xor(v, 4); v += __shfl_xor(v, 8); return v; }
__device__ __forceinline__ float fast_exp(float v) { return __builtin_amdgcn_exp2f(1.4426950408889634f * v); }
__device__ __forceinline__ float sigmoidf_(float v) { return __builtin_amdgcn_rcpf(1.0f + fast_exp(-v)); }
__device__ __forceinline__ bf16x8 mk_frag(unsigned a, unsigned b, unsigned c, unsigned d) { v4u t; t.x = a; t.y = b; t.z = c; t.w = d; return __builtin_bit_cast(bf16x8, t); }
__device__ __forceinline__ bf16x8 ld_frag16(const LAS unsigned char* p) { return *(const LAS bf16x8*)p; }
__device__ __forceinline__ bf16x8 ld_frag8x2(const LAS unsigned char* p0, const LAS unsigned char* p1) {
    const v2u a = *(const LAS v2u*)p0, b = *(const LAS v2u*)p1; return mk_frag(a.x, a.y, b.x, b.y); }
#define MFMA16(a, b, c) __builtin_amdgcn_mfma_f32_16x16x32_bf16((a), (b), (c), 0, 0, 0)

__device__ __forceinline__ void stage_transposed(const bf16* src, size_t spitch, int nrows, int nch, LAS unsigned short* dst, int dpitch, const LAS float* rowscale, int tid) {
    for (int idx = tid; idx < nrows * nch; idx += NWAVES * 64) {
        const int row = idx & (nrows - 1), ch = idx / nrows;
        const v4u q = *(const GAS v4u*)(src + (size_t)row * spitch + ch * 8);
        unsigned e[8] = {q.x & 0xffffu, q.x >> 16, q.y & 0xffffu, q.y >> 16, q.z & 0xffffu, q.z >> 16, q.w & 0xffffu, q.w >> 16};
        LAS unsigned short* d = dst + (ch * 8) * dpitch + row;
        if (rowscale) { const float s = rowscale[row];
#pragma unroll
            for (int j = 0; j < 8; ++j) d[j * dpitch] = (unsigned short)f2bf(bf2f(e[j]) * s); }
        else {
#pragma unroll
            for (int j = 0; j < 8; ++j) d[j * dpitch] = (unsigned short)e[j]; }
    }
}

__device__ __forceinline__ void p0_transpose_item(const float* W, int ldw, bf16* WT, int row_off, LAS float* scr, int kb, int nb, int lane) {
    const int k0 = 64 * kb, n0 = 32 * nb;
#pragma unroll 8
    for (int i = 0; i < 32; ++i) { const int kk = 2 * i + (lane >> 5); scr[kk * 33 + (lane & 31)] = W[(size_t)(k0 + kk) * ldw + n0 + (lane & 31)]; }
    LDS_WAIT(); asm volatile("" ::: "memory");
    const int c = lane & 7;
#pragma unroll
    for (int j = 0; j < 4; ++j) { const int n = (lane >> 3) + 8 * j; const LAS float* s = scr + (8 * c) * 33 + n;
        v4u o; o.x = pk2(s[0 * 33], s[1 * 33]); o.y = pk2(s[2 * 33], s[3 * 33]); o.z = pk2(s[4 * 33], s[5 * 33]); o.w = pk2(s[6 * 33], s[7 * 33]);
        *(GAS v4u*)(WT + (size_t)(row_off + n0 + n) * DM + k0 + 8 * c) = o; }
    LDS_WAIT(); asm volatile("" ::: "memory");
}
__device__ __forceinline__ void p0_prologue(Frame& F) {
    const float* x = in_ptr(F, 0); const float* mem = in_ptr(F, 1); const float* w_in = in_ptr(F, 2); const float* b_i = in_ptr(F, 5); const float* b_f = in_ptr(F, 6); const float* w_mem_kv = in_ptr(F, 10); const float* w_out = in_ptr(F, 11); bf16* ACAT = WSP(bf16, WS_ACAT); bf16* BTCAT = WSP(bf16, WS_BTCAT); bf16* WOT = WSP(bf16, WS_WOT); float* GATES = WSP(float, WS_GATES);
    const int gw = F.vcu * NWAVES + F.wave, NGW = F.G * NWAVES;
    {
        LAS float* scr = (LAS float*)(F.lds + F.wave * 16384);
        constexpr int I0 = 64 * 224, I1 = 64 * 128, I2 = 64 * 64, I3 = 64 * 128, NITEMS = I0 + I1 + I2 + I3;
        for (int it = gw; it < NITEMS; it += NGW) {
            int r = it;
            if (r < I0) { p0_transpose_item(w_in, INW, BTCAT, 0, scr, r / 224, r % 224, F.lane); continue; } r -= I0;
            if (r < I1) { p0_transpose_item(w_in + 7176, INW, BTCAT, 7168, scr, r / 128, r % 128, F.lane); continue; } r -= I1;
            if (r < I2) { p0_transpose_item(w_mem_kv, 2048, BTCAT, 11264, scr, r / 64, r % 64, F.lane); continue; } r -= I2;
            p0_transpose_item(w_out, DM, WOT, 0, scr, r / 128, r % 128, F.lane);
        }
    }
    __syncthreads();
    {
        LAS float* GW = (LAS float*)F.lds;
        for (int idx = F.tid; idx < DM * 8; idx += NWAVES * 64) { const int k = idx >> 3, g = idx & 7; GW[g * DM + k] = w_in[(size_t)k * INW + 7168 + g]; }
        __syncthreads();
        for (int m = gw; m < MROWS; m += NGW) {
            const GAS f32x4* xr = (const GAS f32x4*)(x + (size_t)m * DM) + F.lane;
            GAS unsigned long long* o8 = (GAS unsigned long long*)(ACAT + (size_t)m * DM) + F.lane;
            float acc[8];
#pragma unroll
            for (int g = 0; g < 8; ++g) acc[g] = 0.f;
#pragma unroll 4
            for (int j = 0; j < 16; ++j) {
                const f32x4 v = xr[64 * j];
                o8[64 * j] = (unsigned long long)pk2(v.x, v.y) | ((unsigned long long)pk2(v.z, v.w) << 32);
#pragma unroll
                for (int g = 0; g < 8; ++g) { const f32x4 w = *(const LAS f32x4*)(GW + g * DM + 256 * j + 4 * F.lane); acc[g] += (v.x * w.x + v.y * w.y) + (v.z * w.z + v.w * w.w); }
            }
#pragma unroll
            for (int g = 0; g < 8; ++g) acc[g] = wave_sum(acc[g]);
            if (F.lane < 8) { float r = acc[0];
#pragma unroll
                for (int g = 1; g < 8; ++g) r = (F.lane == g) ? acc[g] : r;
                r += (F.lane < 4) ? b_i[F.lane] : b_f[F.lane - 4];
                GATES[(size_t)m * 8 + F.lane] = r; }
        }
        for (int m = gw; m < MEMROWS; m += NGW) {
            const GAS f32x4* xr = (const GAS f32x4*)(mem + (size_t)m * DM) + F.lane;
            GAS unsigned long long* o8 = (GAS unsigned long long*)(ACAT + (size_t)(MROWS + m) * DM) + F.lane;
#pragma unroll 4
            for (int j = 0; j < 16; ++j) { const f32x4 v = xr[64 * j]; o8[64 * j] = (unsigned long long)pk2(v.x, v.y) | ((unsigned long long)pk2(v.z, v.w) << 32); }
        }
    }
}

__device__ __forceinline__ void swa_item(Frame& F, int item) {
    int tid = F.tid; asm volatile("" : "+v"(tid)); const int lane = tid & 63;
    const float* rel_bias = in_ptr(F, 8); const float* sinks = in_ptr(F, 9); bf16* PROJ = WSP(bf16, WS_PROJ); bf16* MIX = WSP(bf16, WS_MIX);
    const int b = item >> 7, n = (item >> 2) & 31, kv = item & 3;
    const int row0 = b * SEQ + n * 128;
    LAS unsigned char* Ks = F.lds;
    LAS unsigned char* Vt = F.lds + 69632;
    LAS float* BT = (LAS float*)(F.lds + 137216);
    {   const int g = tid >> 7, dist = tid & 127; int bucket = dist;
        if (dist >= 16) { const float ratio = (float)dist / 16.0f; const int lg = 16 + (int)(logf(ratio) / logf(8.0f) * 16.0f); bucket = lg < 31 ? lg : 31; }
        BT[g * 128 + dist] = rel_bias[bucket * 16 + kv * 4 + g]; }
    for (int idx = tid; idx < 256 * 16; idx += NWAVES * 64) {
        const int key = idx & 255, ch = idx >> 8; const bool valid = (n > 0) || (key >= 128);
        v4u kq; kq.x = 0u; kq.y = 0u; kq.z = 0u; kq.w = 0u; v4u vq = kq;
        if (valid) { const bf16* src = PROJ + (size_t)(row0 - 128 + key) * NPROJ + kv * 128 + ch * 8; kq = *(const GAS v4u*)(src + C_AK); vq = *(const GAS v4u*)(src + C_AV); }
        *(LAS v4u*)(Ks + key * 272 + ch * 16) = kq;
        LAS unsigned short* d = (LAS unsigned short*)Vt + (ch * 8) * 264 + key;
        d[0 * 264] = (unsigned short)(vq.x & 0xffffu); d[1 * 264] = (unsigned short)(vq.x >> 16); d[2 * 264] = (unsigned short)(vq.y & 0xffffu); d[3 * 264] = (unsigned short)(vq.y >> 16);
        d[4 * 264] = (unsigned short)(vq.z & 0xffffu); d[5 * 264] = (unsigned short)(vq.z >> 16); d[6 * 264] = (unsigned short)(vq.w & 0xffffu); d[7 * 264] = (unsigned short)(vq.w >> 16);
    }
    __syncthreads();
    const int g = F.wave >> 1, head = kv * 4 + g, l15 = lane & 15, quad = lane >> 4;
    const float sink = sinks[head];
    const float scale = 0.08838834764831845f;
    for (int sub = 0; sub < 4; ++sub) {
        const int q0 = (F.wave & 1) * 64 + sub * 16, kbase = q0 & ~31;
        const int qi = q0 + l15;
        bf16x8 qf[4];
        { const bf16* qp = PROJ + (size_t)(row0 + qi) * NPROJ + C_AQ + head * 128 + 8 * quad;
#pragma unroll
          for (int ks = 0; ks < 4; ++ks) qf[ks] = __builtin_bit_cast(bf16x8, *(const GAS v4u*)(qp + 32 * ks)); }
        f32x4 st[10];
#pragma unroll
        for (int kt = 0; kt < 10; ++kt) { f32x4 a = {0.f, 0.f, 0.f, 0.f}; const LAS unsigned char* kp = Ks + (kbase + 16 * kt + l15) * 272 + 16 * quad;
#pragma unroll
            for (int ks = 0; ks < 4; ++ks) a = MFMA16(ld_frag16(kp + 64 * ks), qf[ks], a);
            st[kt] = a; }
        float mx = sink;
#pragma unroll
        for (int kt = 0; kt < 10; ++kt)
#pragma unroll
            for (int r = 0; r < 4; ++r) { const int si = kbase + 16 * kt + 4 * quad + r, dist = qi + 128 - si;
                const bool ok = (dist >= 0) && (dist < 128) && ((n > 0) || (si >= 128));
                const float s = ok ? st[kt][r] * scale + BT[g * 128 + (dist & 127)] : -INFINITY;
                st[kt][r] = s; mx = fmaxf(mx, s); }
        mx = quad_max(mx);
        float sum = 0.f;
#pragma unroll
        for (int kt = 0; kt < 10; ++kt)
#pragma unroll
            for (int r = 0; r < 4; ++r) { const float p = fast_exp(st[kt][r] - mx); st[kt][r] = p; sum += p; }
        sum = quad_sum(sum) + fast_exp(sink - mx);
        const float inv = 1.0f / sum;
        f32x4 o[8];
#pragma unroll
        for (int dt = 0; dt < 8; ++dt) o[dt] = (f32x4){0.f, 0.f, 0.f, 0.f};
#pragma unroll
        for (int kp = 0; kp < 5; ++kp) {
            const f32x4 p0 = st[2 * kp] * inv, p1 = st[2 * kp + 1] * inv;
            const bf16x8 a = mk_frag(pg8::cvt_pk_bf16(p0[0], p0[1]), pg8::cvt_pk_bf16(p0[2], p0[3]), pg8::cvt_pk_bf16(p1[0], p1[1]), pg8::cvt_pk_bf16(p1[2], p1[3]));
            const LAS unsigned char* vp = Vt + (l15 * 264 + kbase + 32 * kp + 4 * quad) * 2;
#pragma unroll
            for (int dt = 0; dt < 8; ++dt) o[dt] = MFMA16(a, ld_frag8x2(vp + dt * 16 * 528, vp + dt * 16 * 528 + 32), o[dt]);
        }
#pragma unroll
        for (int r = 0; r < 4; ++r) { const size_t row = (size_t)(row0 + q0 + 4 * quad + r);
            const bf16* zp = PROJ + row * NPROJ + C_AZ + head * 128 + l15; bf16* op = MIX + row * DM + head * 128 + l15;
#pragma unroll
            for (int dt = 0; dt < 8; ++dt) op[16 * dt] = (bf16)f2bf(o[dt][r] * bf2f(zp[16 * dt])); }
    }
    __syncthreads();
}

__device__ __forceinline__ void cross_item(Frame& F, int item) {
    int tid = F.tid; asm volatile("" : "+v"(tid)); const int lane = tid & 63;
    bf16* PROJ = WSP(bf16, WS_PROJ); bf16* MKV = WSP(bf16, WS_MKV); bf16* MIX = WSP(bf16, WS_MIX);
    const int b = item >> 7, h = (item >> 5) & 3, qt = item & 31;
    LAS unsigned char* Ks = F.lds;
    for (int idx = tid; idx < 256 * 32; idx += NWAVES * 64) { const int m = idx >> 5, ch = idx & 31;
        *(LAS v4u*)(Ks + m * 528 + ch * 16) = *(const GAS v4u*)(MKV + (size_t)(b * 256 + m) * 2048 + h * 256 + ch * 8); }
    __syncthreads();
    const int l15 = lane & 15, quad = lane >> 4;
    const size_t qrow = (size_t)b * SEQ + qt * 128 + F.wave * 16;
    bf16x8 pa[8];
    {
        bf16x8 qf[8];
        { const bf16* qp = PROJ + (qrow + l15) * NPROJ + C_CQ + h * 256 + 8 * quad;
#pragma unroll
          for (int ks = 0; ks < 8; ++ks) qf[ks] = __builtin_bit_cast(bf16x8, *(const GAS v4u*)(qp + 32 * ks)); }
        f32x4 st[16];
#pragma unroll
        for (int kt = 0; kt < 16; ++kt) { f32x4 a = {0.f, 0.f, 0.f, 0.f}; const LAS unsigned char* kp = Ks + (16 * kt + l15) * 528 + 16 * quad;
#pragma unroll
            for (int ks = 0; ks < 8; ++ks) a = MFMA16(ld_frag16(kp + 64 * ks), qf[ks], a);
            st[kt] = a; }
        float mx = -INFINITY;
#pragma unroll
        for (int kt = 0; kt < 16; ++kt)
#pragma unroll
            for (int r = 0; r < 4; ++r) { const float s = st[kt][r] * 0.0625f; st[kt][r] = s; mx = fmaxf(mx, s); }
        mx = quad_max(mx);
        float sum = 0.f;
#pragma unroll
        for (int kt = 0; kt < 16; ++kt)
#pragma unroll
            for (int r = 0; r < 4; ++r) { const float p = fast_exp(st[kt][r] - mx); st[kt][r] = p; sum += p; }
        sum = quad_sum(sum);
        const float inv = 1.0f / sum;
#pragma unroll
        for (int kp = 0; kp < 8; ++kp) { const f32x4 p0 = st[2 * kp] * inv, p1 = st[2 * kp + 1] * inv;
            pa[kp] = mk_frag(pg8::cvt_pk_bf16(p0[0], p0[1]), pg8::cvt_pk_bf16(p0[2], p0[3]), pg8::cvt_pk_bf16(p1[0], p1[1]), pg8::cvt_pk_bf16(p1[2], p1[3])); }
    }
    __syncthreads();
    stage_transposed(MKV + (size_t)(b * 256) * 2048 + 1024 + h * 256, 2048, 256, 32, (LAS unsigned short*)F.lds, 264, nullptr, tid);
    __syncthreads();
    f32x4 o[16];
#pragma unroll
    for (int dt = 0; dt < 16; ++dt) o[dt] = (f32x4){0.f, 0.f, 0.f, 0.f};
#pragma unroll
    for (int kp = 0; kp < 8; ++kp) { const LAS unsigned char* vp = F.lds + (l15 * 264 + 32 * kp + 4 * quad) * 2;
#pragma unroll
        for (int dt = 0; dt < 16; ++dt) o[dt] = MFMA16(pa[kp], ld_frag8x2(vp + dt * 16 * 528, vp + dt * 16 * 528 + 32), o[dt]); }
#pragma unroll
    for (int r = 0; r < 4; ++r) { const size_t row = qrow + 4 * quad + r;
        const bf16* zp = PROJ + row * NPROJ + C_CZ + h * 256 + l15; bf16* op = MIX + row * DM + 3072 + h * 256 + l15;
#pragma unroll
        for (int dt = 0; dt < 16; ++dt) op[16 * dt] = (bf16)f2bf(o[dt][r] * bf2f(zp[16 * dt])); }
    __syncthreads();
}

__device__ __forceinline__ float log_sigmoid_f(float v) { return fminf(v, 0.f) - log1pf(expf(-fabsf(v))); }
template <int OP> __device__ __forceinline__ void wave_scan128(const LAS float* in, LAS float* out, int lane) {
    const float e0 = in[2 * lane], e1 = in[2 * lane + 1];
    float s = OP ? fmaxf(e0, e1) : (e0 + e1);
#pragma unroll
    for (int o = 1; o < 64; o <<= 1) { const float t = __shfl_up(s, o); if (lane >= o) s = OP ? fmaxf(s, t) : (s + t); }
    float ex = __shfl_up(s, 1);
    if (OP) { const float a = (lane == 0) ? e0 : fmaxf(ex, e0); out[2 * lane] = a; out[2 * lane + 1] = fmaxf(a, e1); }
    else { const float a = (lane == 0) ? e0 : (ex + e0); out[2 * lane] = a; out[2 * lane + 1] = a + e1; }
}

__device__ __forceinline__ void cloc_item(Frame& F, int item) {
    int tid = F.tid; asm volatile("" : "+v"(tid)); const int lane = tid & 63;
    const float* conv_w = in_ptr(F, 3); const float* conv_b = in_ptr(F, 4); bf16* PROJ = WSP(bf16, WS_PROJ); bf16* MQK = WSP(bf16, WS_MQK); float* GATES = WSP(float, WS_GATES); float* CLOC = WSP(float, WS_CLOC); float* CST = WSP(float, WS_SMALL);
    const int b = item >> 7, h = (item >> 5) & 3, c = item & 31;
    const int r0 = b * SEQ + c * 128;
    LAS unsigned short* VT = (LAS unsigned short*)F.lds;
    LAS unsigned short* KT = (LAS unsigned short*)(F.lds + 73984);
    LAS float* LI = (LAS float*)(F.lds + 73984 + 34816); LAS float* LF = LI + 128; LAS float* BB = LF + 128; LAS float* WW = BB + 128;
    {
        const int col = tid & 255, half = tid >> 8, isk = col >> 7, cc = col & 127;
        const int ch = isk * 512 + h * 128 + cc;
        const float w0 = conv_w[ch], w1 = conv_w[1024 + ch], w2 = conv_w[2048 + ch], w3 = conv_w[3072 + ch], cb = conv_b[ch];
        const bf16* src = PROJ + (size_t)r0 * NPROJ + (isk ? C_MK : C_MQ) + h * 128 + cc;
        const int s0 = half * 64;
        float x0 = 0.f, x1 = 0.f, x2 = 0.f;
        if (c * 128 + s0 >= 3) { x0 = bf2f(src[(ptrdiff_t)(s0 - 3) * NPROJ]); x1 = bf2f(src[(ptrdiff_t)(s0 - 2) * NPROJ]); x2 = bf2f(src[(ptrdiff_t)(s0 - 1) * NPROJ]); }
        bf16* dst = MQK + (size_t)r0 * 1024 + isk * 512 + h * 128 + cc;
        for (int s = s0; s < s0 + 64; ++s) {
            const float x3 = bf2f(src[(size_t)s * NPROJ]);
            const float y = w0 * x0 + w1 * x1 + w2 * x2 + w3 * x3 + cb;
            float v = y * sigmoidf_(y); if (isk) v *= 0.08838834764831845f;
            const unsigned hv = f2bf(v);
            dst[(size_t)s * 1024] = (bf16)hv;
            if (isk) KT[cc * 136 + s] = (unsigned short)hv;
            x0 = x1; x1 = x2; x2 = x3;
        }
    }
    if (tid < 128) { const float li = GATES[(size_t)(r0 + tid) * 8 + h], fp = GATES[(size_t)(r0 + tid) * 8 + 4 + h]; LI[tid] = li; LF[tid] = log_sigmoid_f(fp); }
    __syncthreads();
    if (F.wave == 0) wave_scan128<0>(LF, BB, lane);
    __syncthreads();
    if (F.wave == 0) {
        const float gl = BB[127];
        const float a0 = gl - BB[2 * lane] + LI[2 * lane], a1 = gl - BB[2 * lane + 1] + LI[2 * lane + 1];
        float mx = fmaxf(a0, a1);
#pragma unroll
        for (int o = 1; o < 64; o <<= 1) mx = fmaxf(mx, __shfl_xor(mx, o));
        WW[2 * lane] = expf(a0 - mx); WW[2 * lane + 1] = expf(a1 - mx);
        if (lane == 0) { CST[item * 2] = gl; CST[item * 2 + 1] = mx; }
    }
    __syncthreads();
    stage_transposed(PROJ + (size_t)r0 * NPROJ + C_MV + h * 256, NPROJ, 128, 32, VT, 136, WW, tid);
    if (tid < 128) VT[256 * 136 + tid] = (unsigned short)f2bf(WW[tid]);
    for (int idx = tid; idx < 15 * 136; idx += NWAVES * 64) VT[257 * 136 + idx] = 0;
    __syncthreads();
    {
        const int l15 = lane & 15, quad = lane >> 4;
        float* outp = CLOC + (size_t)item * (257 * 128);
        for (int mt = F.wave; mt < 17; mt += 8) {
            bf16x8 af[4];
#pragma unroll
            for (int ks = 0; ks < 4; ++ks) af[ks] = ld_frag16((const LAS unsigned char*)(VT + (16 * mt + l15) * 136 + 32 * ks + 8 * quad));
#pragma unroll
            for (int nt = 0; nt < 8; ++nt) { f32x4 a = {0.f, 0.f, 0.f, 0.f};
#pragma unroll
                for (int ks = 0; ks < 4; ++ks) a = MFMA16(af[ks], ld_frag16((const LAS unsigned char*)(KT + (16 * nt + l15) * 136 + 32 * ks + 8 * quad)), a);
#pragma unroll
                for (int r = 0; r < 4; ++r) { const int v = 16 * mt + 4 * quad + r; if (v < 257) outp[(size_t)v * 128 + 16 * nt + l15] = a[r]; } }
        }
    }
    __syncthreads();
}

__device__ __forceinline__ void scan_phase(Frame& F) {
    float* CLOC = WSP(float, WS_CLOC); bf16* CPREV = WSP(bf16, WS_CPREV); float* CST = WSP(float, WS_SMALL); float* MPREV = WSP(float, WS_SMALL + 4096);
    const int gt = F.vcu * (NWAVES * 64) + F.tid, NT = F.G * NWAVES * 64;
    constexpr int PAIRS = 257 * 64;
    for (int p = gt; p < 8 * PAIRS; p += NT) {
        const int bh = p / PAIRS, off = (p % PAIRS) * 2;
        float m = 0.f, c0 = 0.f, c1 = 0.f;
        for (int c = 0; c < 32; ++c) {
            const int item = bh * 32 + c;
            const float gl = CST[item * 2], ml = CST[item * 2 + 1];
            const float2 cl = *(const float2*)(CLOC + (size_t)item * (257 * 128) + off);
            *(unsigned*)(CPREV + (size_t)item * (257 * 128) + off) = pk2(c0, c1);
            if (off == 0) MPREV[item] = m;
            const float mn = fmaxf(gl + m, ml), sp = expf(gl + m - mn), sl = expf(ml - mn);
            c0 = sp * c0 + sl * cl.x; c1 = sp * c1 + sl * cl.y; m = mn;
        }
    }
}

__device__ __forceinline__ void mout_item(Frame& F, int item) {
    int tid = F.tid; asm volatile("" : "+v"(tid)); const int lane = tid & 63;
    const float* m_norm_g = in_ptr(F, 7); bf16* PROJ = WSP(bf16, WS_PROJ); bf16* MQK = WSP(bf16, WS_MQK); bf16* CPREV = WSP(bf16, WS_CPREV); float* GATES = WSP(float, WS_GATES); float* MPREV = WSP(float, WS_SMALL + 4096); bf16* MIX = WSP(bf16, WS_MIX);
    const int b = item >> 7, h = (item >> 5) & 3, c = item & 31;
    const int r0 = b * SEQ + c * 128;
    LAS unsigned short* VT2 = (LAS unsigned short*)F.lds;
    LAS unsigned char* CP = F.lds + 73984;
    LAS float* LI = (LAS float*)(F.lds + 2 * 73984); LAS float* LF = LI + 128; LAS float* BB = LF + 128; LAS float* UU = BB + 128; LAS float* MM = UU + 128;
    const float mprev = MPREV[item];
    stage_transposed(PROJ + (size_t)r0 * NPROJ + C_MV + h * 256, NPROJ, 128, 32, VT2, 136, nullptr, tid);
    if (tid < 128) VT2[256 * 136 + tid] = 0x3F80;
    for (int idx = tid; idx < 15 * 136; idx += NWAVES * 64) VT2[257 * 136 + idx] = 0;
    for (int idx = tid; idx < 272 * 16; idx += NWAVES * 64) { const int row = idx >> 4, ch = idx & 15;
        v4u q; q.x = 0u; q.y = 0u; q.z = 0u; q.w = 0u;
        if (row < 257) q = *(const GAS v4u*)(CPREV + (size_t)item * (257 * 128) + row * 128 + ch * 8);
        *(LAS v4u*)(CP + row * 272 + ch * 16) = q; }
    if (tid < 128) { const float li = GATES[(size_t)(r0 + tid) * 8 + h], fp = GATES[(size_t)(r0 + tid) * 8 + 4 + h]; LI[tid] = li; LF[tid] = log_sigmoid_f(fp); }
    __syncthreads();
    if (F.wave == 0) wave_scan128<0>(LF, BB, lane);
    __syncthreads();
    if (F.wave == 0) { UU[2 * lane] = LI[2 * lane] - BB[2 * lane]; UU[2 * lane + 1] = LI[2 * lane + 1] - BB[2 * lane + 1]; }
    __syncthreads();
    if (F.wave == 0) wave_scan128<1>(UU, MM, lane);
    __syncthreads();
    if (tid < 128) MM[tid] = fmaxf(MM[tid], mprev);
    __syncthreads();
    const int l15 = lane & 15, quad = lane >> 4, t0 = 16 * F.wave;
    bf16x8 a1[4], a2[4];
    {
        bf16x8 qf[4];
        { const bf16* qp = MQK + (size_t)(r0 + t0 + l15) * 1024 + h * 128 + 8 * quad;
#pragma unroll
          for (int ks = 0; ks < 4; ++ks) qf[ks] = __builtin_bit_cast(bf16x8, *(const GAS v4u*)(qp + 32 * ks)); }
        const float Mt = MM[t0 + l15];
        f32x4 sT[8];
#pragma unroll
        for (int st = 0; st < 8; ++st) { f32x4 a = {0.f, 0.f, 0.f, 0.f};
            { const bf16* kp = MQK + (size_t)(r0 + 16 * st + l15) * 1024 + 512 + h * 128 + 8 * quad;
#pragma unroll
                for (int ks = 0; ks < 4; ++ks) a = MFMA16(__builtin_bit_cast(bf16x8, *(const GAS v4u*)(kp + 32 * ks)), qf[ks], a); }
#pragma unroll
            for (int r = 0; r < 4; ++r) { const int s = 16 * st + 4 * quad + r; a[r] = (s <= t0 + l15) ? a[r] * fast_exp(UU[s] - Mt) : 0.f; }
            sT[st] = a; }
#pragma unroll
        for (int kp = 0; kp < 4; ++kp) { const f32x4 p0 = sT[2 * kp], p1 = sT[2 * kp + 1];
            a1[kp] = mk_frag(pg8::cvt_pk_bf16(p0[0], p0[1]), pg8::cvt_pk_bf16(p0[2], p0[3]), pg8::cvt_pk_bf16(p1[0], p1[1]), pg8::cvt_pk_bf16(p1[2], p1[3])); }
        const float wi = fast_exp(mprev - Mt);
#pragma unroll
        for (int ks = 0; ks < 4; ++ks) { const v4u q = __builtin_bit_cast(v4u, qf[ks]);
            a2[ks] = mk_frag(pg8::cvt_pk_bf16(bf2f(q.x & 0xffffu) * wi, bf2f(q.x >> 16) * wi), pg8::cvt_pk_bf16(bf2f(q.y & 0xffffu) * wi, bf2f(q.y >> 16) * wi),
                             pg8::cvt_pk_bf16(bf2f(q.z & 0xffffu) * wi, bf2f(q.z >> 16) * wi), pg8::cvt_pk_bf16(bf2f(q.w & 0xffffu) * wi, bf2f(q.w >> 16) * wi)); }
    }
    f32x4 num[17];
#pragma unroll
    for (int vt = 0; vt < 17; ++vt) { f32x4 a = {0.f, 0.f, 0.f, 0.f};
        const LAS unsigned char* vp = (const LAS unsigned char*)(VT2 + (16 * vt + l15) * 136 + 4 * quad);
        const LAS unsigned char* cp = CP + (16 * vt + l15) * 272 + 16 * quad;
#pragma unroll
        for (int kp = 0; kp < 4; ++kp) a = MFMA16(a1[kp], ld_frag8x2(vp + 64 * kp, vp + 64 * kp + 32), a);
#pragma unroll
        for (int ks = 0; ks < 4; ++ks) a = MFMA16(a2[ks], ld_frag16(cp + 64 * ks), a);
        num[vt] = a; }
    const float* ng = m_norm_g + h * 256 + l15;
#pragma unroll
    for (int r = 0; r < 4; ++r) {
        const int t = t0 + 4 * quad + r; const size_t row = (size_t)(r0 + t);
        const float den = __shfl(num[16][r], lane & 48);
        const float mt = BB[t] + MM[t];
        const float inv = 1.0f / fmaxf(fabsf(den), expf(-mt));
        const bf16* op = PROJ + row * NPROJ + C_MO + h * 256 + l15; const bf16* zp = PROJ + row * NPROJ + C_MZ + h * 256 + l15;
        float hv[16]; float s = 0.f;
#pragma unroll
        for (int vt = 0; vt < 16; ++vt) { hv[vt] = num[vt][r] * inv * bf2f(op[16 * vt]); s += hv[vt]; }
        const float mean = row16_sum(s) * (1.0f / 256.0f);
        float q = 0.f;
#pragma unroll
        for (int vt = 0; vt < 16; ++vt) { hv[vt] -= mean; q += hv[vt] * hv[vt]; }
        const float rstd = 1.0f / sqrtf(row16_sum(q) * (1.0f / 256.0f) + HEAD_NORM_EPS);
        bf16* mp = MIX + row * DM + 2048 + h * 256 + l15;
#pragma unroll
        for (int vt = 0; vt < 16; ++vt) mp[16 * vt] = (bf16)f2bf(hv[vt] * rstd * ng[16 * vt] * bf2f(zp[16 * vt]));
    }
    __syncthreads();
}

__device__ __forceinline__ void ln_phase(Frame& F) {
    const float* x = in_ptr(F, 0); const float* ln_g = in_ptr(F, 12); const float* ln_b = in_ptr(F, 13); float* out = out_ptr(F); bf16* Y = WSP(bf16, WS_Y);
    const int gw = F.vcu * NWAVES + F.wave, NGW = F.G * NWAVES;
    for (int m = gw; m < MROWS; m += NGW) {
        const GAS f32x4* xr = (const GAS f32x4*)(x + (size_t)m * DM) + F.lane;
        const GAS v2u* yr = (const GAS v2u*)(Y + (size_t)m * DM) + F.lane;
        f32x4 v[16]; float s = 0.f;
#pragma unroll
        for (int j = 0; j < 16; ++j) { const f32x4 xv = xr[64 * j]; const v2u yv = yr[64 * j];
            v[j].x = DEEPNORM_ALPHA * xv.x + bf2f(yv.x & 0xffffu); v[j].y = DEEPNORM_ALPHA * xv.y + bf2f(yv.x >> 16);
            v[j].z = DEEPNORM_ALPHA * xv.z + bf2f(yv.y & 0xffffu); v[j].w = DEEPNORM_ALPHA * xv.w + bf2f(yv.y >> 16);
            s += (v[j].x + v[j].y) + (v[j].z + v[j].w); }
        const float mean = wave_sum(s) * (1.0f / DM); float s2 = 0.f;
#pragma unroll
        for (int j = 0; j < 16; ++j) { v[j] = v[j] - mean; s2 += (v[j].x * v[j].x + v[j].y * v[j].y) + (v[j].z * v[j].z + v[j].w * v[j].w); }
        const float rstd = 1.0f / sqrtf(wave_sum(s2) * (1.0f / DM) + LN_EPS);
        GAS f32x4* orow = (GAS f32x4*)(out + (size_t)m * DM) + F.lane;
        const GAS f32x4* gr = (const GAS f32x4*)ln_g + F.lane; const GAS f32x4* br = (const GAS f32x4*)ln_b + F.lane;
#pragma unroll
        for (int j = 0; j < 16; ++j) orow[64 * j] = v[j] * rstd * gr[64 * j] + br[64 * j];
    }
}

#ifndef MK_N_LAUNCHES
#define MK_N_LAUNCHES 7
#endif
constexpr int N_PHASES = 7;
struct Args { const float* in[14]; float* out; unsigned char* ws; int ph_lo, ph_hi; };
__global__ void __launch_bounds__(NWAVES * 64, 2) hymba_fwd(Args args) {
    extern __shared__ __attribute__((aligned(16))) unsigned char lds[];
    Frame F;
    F.lds = (LAS unsigned char*)lds;
    F.MISC = (volatile LAS unsigned*)(F.lds + MISC_OFF);
    F.tid = threadIdx.x; F.lane = F.tid & 63; F.wave = __builtin_amdgcn_readfirstlane(F.tid >> 6);
    F.G = gridDim.x; { const int bx = blockIdx.x; F.vcu = (F.G % 8 == 0) ? (bx % 8) * (F.G / 8) + bx / 8 : bx; }
    F.ws = args.ws; F.ctl = (gu32*)(args.ws + WS_CTL); F.kargs = (const CAS unsigned char*)__builtin_amdgcn_kernarg_segment_ptr();
    if (F.tid < 64) ((LAS unsigned*)(F.lds + MISC_OFF))[F.tid] = 0u;
    __syncthreads();
    const int lo = args.ph_lo, hi = args.ph_hi;
    XcdBarrier bar; bar.bar = (unsigned*)(F.ctl + CW_BAR); bar.x = 0; bar.st = nullptr;
    if (hi - lo > 1) bar = xcd_barrier_post((unsigned*)(F.ctl + CW_BAR), F.MISC + 8);
#ifdef ONLY_PHASE
#define IN(k) ((k) == ONLY_PHASE)
#else
#define IN(k) (lo <= (k) && (k) < hi)
#endif
#define BOTH(k) (IN(k) && IN((k) + 1))
    if (IN(0)) { p0_prologue(F); if (BOTH(0)) xcd_barrier(bar); }
    if (IN(1)) {
        pg8::Gemm g{WSP(bf16, WS_ACAT), WSP(bf16, WS_BTCAT), MROWS + MEMROWS, NPROJ + 2048, DM}; pg8::InProjOrder S; S.G = F.G; S.c = (int)blockIdx.x;
        pg8::EpiProj E{WSP(bf16, WS_PROJ), NPROJ, WSP(bf16, WS_MKV), 2048};
        pg8::gemm_phase<pg8::EpiProj, pg8::InProjOrder, true, true>(F.lds, g, S, E);
        if (BOTH(1)) xcd_barrier(bar);
    }
    if (IN(2)) {
        for (int it = F.vcu; it < 256; it += F.G) cloc_item(F, it);
        for (int it = F.vcu; it < 256; it += F.G) swa_item(F, it);
        if (BOTH(2)) xcd_barrier(bar);
    }
    if (IN(3)) {
        scan_phase(F);
        for (int it = F.vcu; it < 256; it += F.G) cross_item(F, it);
        if (BOTH(3)) xcd_barrier(bar);
    }
    if (IN(4)) {
        for (int it = F.vcu; it < 256; it += F.G) mout_item(F, it);
        if (BOTH(4)) xcd_barrier(bar);
    }
    if (IN(5)) {
        pg8::Gemm g{WSP(bf16, WS_MIX), WSP(bf16, WS_WOT), MROWS, DM, DM}; pg8::StaticOrder S; S.init(MROWS, DM, F.G, (int)blockIdx.x);
        pg8::EpiY E{WSP(bf16, WS_Y), DM};
        pg8::gemm_phase<pg8::EpiY, pg8::StaticOrder, true, true>(F.lds, g, S, E);
        if (BOTH(5)) xcd_barrier(bar);
    }
    if (IN(6)) ln_phase(F);
#undef IN
#undef BOTH
}

extern "C" void kernel_launch(void* const* d_in, const int* in_sizes, int n_in, void* d_out, int out_size, void* d_ws, size_t ws_size, hipStream_t stream) {
    static int grid = 0;
    if (grid == 0) {
        if (n_in != 14 || in_sizes[0] != MROWS * DM || out_size != MROWS * DM || ws_size < WS_END) { fprintf(stderr, "kernel_launch: unexpected shapes (n_in %d, in0 %d, out %d, ws %zu); nothing launched\n", n_in, n_in > 0 ? in_sizes[0] : -1, out_size, ws_size); grid = -1; return; }
        int dev = 0, cus = 0, per_cu = 0;
        if (hipGetDevice(&dev) != hipSuccess || hipDeviceGetAttribute(&cus, hipDeviceAttributeMultiprocessorCount, dev) != hipSuccess) { grid = -1; return; }
        if (hipFuncSetAttribute((const void*)hymba_fwd, hipFuncAttributeMaxDynamicSharedMemorySize, LDS_BYTES) != hipSuccess) { fprintf(stderr, "kernel_launch: hipFuncSetAttribute failed\n"); grid = -1; return; }
        if (hipOccupancyMaxActiveBlocksPerMultiprocessor(&per_cu, (const void*)hymba_fwd, NWAVES * 64, LDS_BYTES) != hipSuccess || per_cu < 1) { fprintf(stderr, "kernel_launch: occupancy query says %d blocks per CU; nothing launched\n", per_cu); (void)hipGetLastError(); grid = -1; return; }
        grid = cus;
    }
    if (grid < 0) return;
    (void)hipMemsetAsync((char*)d_ws + WS_CTL, 0, CTL_ZERO_BYTES, stream);
    Args a{};
    for (int i = 0; i < 14; ++i) a.in[i] = (const float*)d_in[i];
    a.out = (float*)d_out; a.ws = (unsigned char*)d_ws;
#if MK_N_LAUNCHES == 1
    a.ph_lo = 0; a.ph_hi = N_PHASES;
    void* kargs[] = {&a};
    const hipError_t le = hipLaunchCooperativeKernel((const void*)hymba_fwd, dim3(grid), dim3(NWAVES * 64), kargs, LDS_BYTES, stream);
    if (le != hipSuccess) fprintf(stderr, "kernel_launch: cooperative launch failed: %s (grid %d)\n", hipGetErrorString(le), grid);
#else
    for (int p = 0; p < N_PHASES; ++p) { a.ph_lo = p; a.ph_hi = p + 1; hipLaunchKernelGGL(hymba_fwd, dim3(grid), dim3(NWAVES * 64), LDS_BYTES, stream, a); }
#endif
}
```

```cpp
#include <hip/hip_runtime.h>
#include <cstdio>
#include <cstdint>
#include <cstddef>
namespace pg8 {
#define PG8_LAS __attribute__((address_space(3)))
typedef unsigned short bf16_t;
typedef short bf16x8 __attribute__((ext_vector_type(8)));
typedef float f32x4 __attribute__((ext_vector_type(4)));
typedef unsigned u32x4 __attribute__((ext_vector_type(4)));
constexpr int BM = 256, BK = 64, HALF = 128, HTB = HALF * BK * 2  , STAGE_BYTES = 8 * HTB, NXCD = 8, WGM = 8;

__host__ __device__ __forceinline__ int lds_byte(int r, int c) { const int st = (r >> 4) * 2 + (c >> 5), rr = r & 15, cc = c & 31, ob = rr * 64 + cc * 2; return st * 1024 + (ob ^ (((ob >> 9) & 1) << 5)); }
__host__ __device__ __forceinline__ void stage_rc(int b, int& R, int& C) { const int st = b / 1024, sb = b % 1024, swz = sb ^ (((sb >> 9) & 1) << 5); R = (st >> 1) * 16 + swz / 64; C = (st & 1) * 32 + (swz % 64) / 2; }
__host__ __device__ __forceinline__ int perm32(int rho) { const int n = rho >> 4, i = rho & 15; return 8 * (i >> 2) + 4 * n + (i & 3); }

struct Unit { int pm, pn, tag; };
struct Gemm { const bf16_t* A; const bf16_t* Bt; int M, N, K; };

struct StaticOrder {
    int nM, nN, nwg, G, c;
    __host__ __device__ void init(int M, int N, int G_, int c_) { nM = M / BM; nN = N / BM; nwg = nM * nN; G = G_; c = c_; }
    __host__ __device__ bool next(int i, Unit& u) const {
        const long L = (long)i * G + c; if (L >= nwg) return false;
        int wgid = (int)L; { const int q = nwg / NXCD, r = nwg % NXCD, xcd = wgid % NXCD, off = wgid / NXCD; wgid = (xcd < r ? xcd * (q + 1) : r * (q + 1) + (xcd - r) * q) + off; }
        const int nig = WGM * nN, gid = wgid / nig, fm = gid * WGM, gsz = (nM - fm) < WGM ? (nM - fm) : WGM;
        u.pm = fm + ((wgid % nig) % gsz); u.pn = (wgid % nig) / gsz; u.tag = 0; return true;
    }
    __device__ __forceinline__ void a_ready(const Unit&) const {}
    __device__ __forceinline__ void done(const Unit&) const {}
};
__device__ __forceinline__ unsigned cvt_pk_bf16(float lo, float hi) { unsigned r; asm volatile("v_cvt_pk_bf16_f32 %0, %1, %2" : "=v"(r) : "v"(lo), "v"(hi)); return r; }
typedef float f32x2 __attribute__((ext_vector_type(2)));
__device__ __forceinline__ float sigmoid_f(float v) { return __builtin_amdgcn_rcpf(1.0f + __builtin_amdgcn_exp2f(-1.4426950408889634f * v)); }
struct EpiProj {
    static constexpr bool PERM = true, AFTER_DRAIN = false;
    bf16_t* P; int ldp; bf16_t* MKV; int ldm;
    __device__ __forceinline__ void operator()(const f32x4 (&acc)[2][2][4][2], const Unit& u, int wr, int wc, int fr, int fq) const {
        bf16_t* tbase; unsigned tbytes; unsigned boff; int ld; int act = 0;
        if (u.pm < 32) { tbase = P; tbytes = 8192u * 11264u * 2u; boff = (unsigned)(u.pm * BM) * (unsigned)ldp + (unsigned)(u.pn * BM); ld = ldp; const int pn = u.pn;
            act = ((pn >= 12 && pn < 20) || (pn >= 32 && pn < 36) || pn >= 40) ? 1 : ((pn >= 28 && pn < 32) ? 2 : 0); }
        else { tbase = MKV; tbytes = 512u * 2048u * 2u; boff = (unsigned)((u.pm - 32) * BM) * (unsigned)ldm + (unsigned)((u.pn - 44) * BM); ld = ldm; }
        const __amdgpu_buffer_rsrc_t rsrc = __builtin_amdgcn_make_buffer_rsrc(tbase, 0, tbytes, 0x00020000);
        const int row0 = wr * 64 + fr, col0 = wc * 32 + 8 * fq;
#pragma unroll
        for (int ai = 0; ai < 2; ++ai)
#pragma unroll
            for (int m = 0; m < 4; ++m) { const unsigned rowoff = (boff + (unsigned)(row0 + ai * HALF + m * 16) * (unsigned)ld + (unsigned)col0) * 2u;
#pragma unroll
                for (int bj = 0; bj < 2; ++bj) { f32x4 v0 = acc[ai][bj][m][0], v1 = acc[ai][bj][m][1];
                    if (act == 1) {
#pragma unroll
                        for (int j = 0; j < 4; ++j) { v0[j] = v0[j] * sigmoid_f(v0[j]); v1[j] = v1[j] * sigmoid_f(v1[j]); } }
                    else if (act == 2) {
#pragma unroll
                        for (int j = 0; j < 4; ++j) { v0[j] = sigmoid_f(v0[j]); v1[j] = sigmoid_f(v1[j]); } }
                    u32x4 w; w.x = cvt_pk_bf16(v0[0], v0[1]); w.y = cvt_pk_bf16(v0[2], v0[3]); w.z = cvt_pk_bf16(v1[0], v1[1]); w.w = cvt_pk_bf16(v1[2], v1[3]);
                    __builtin_amdgcn_raw_buffer_store_b128(w, rsrc, rowoff + (unsigned)(bj * HALF * 2), 0, 16  ); } }
    }
};
struct EpiY {
    static constexpr bool PERM = true, AFTER_DRAIN = false;
    bf16_t* O; int ldc;
    __device__ __forceinline__ void operator()(const f32x4 (&acc)[2][2][4][2], const Unit& u, int wr, int wc, int fr, int fq) const {
        bf16_t* base = O + (size_t)(u.pm * BM) * ldc + u.pn * BM;
        const int row0 = wr * 64 + fr, col0 = wc * 32 + 8 * fq;
#pragma unroll
        for (int ai = 0; ai < 2; ++ai)
#pragma unroll
            for (int m = 0; m < 4; ++m) { bf16_t* rowp = base + (size_t)(row0 + ai * HALF + m * 16) * ldc + col0;
#pragma unroll
                for (int bj = 0; bj < 2; ++bj) { const f32x4 v0 = acc[ai][bj][m][0], v1 = acc[ai][bj][m][1];
                    u32x4 w; w.x = cvt_pk_bf16(v0[0], v0[1]); w.y = cvt_pk_bf16(v0[2], v0[3]); w.z = cvt_pk_bf16(v1[0], v1[1]); w.w = cvt_pk_bf16(v1[2], v1[3]);
                    *(u32x4*)(rowp + bj * HALF) = w; } }
    }
};
struct InProjOrder {
    int G, c; unsigned* early;
    __device__ __forceinline__ bool next(int i, Unit& u) const {
        const int L = i * G + c; if (L >= 1424) return false;
        u.tag = (L >= 1280) ? 2 : ((L + G >= 1280) ? 1 : 0);
        if (L < 16) { u.pm = 32 + (L >> 3); u.pn = 44 + (L & 7); return true; }
        const int Lp = L - 16, xcd = Lp % NXCD, off = Lp / NXCD;
        const int ci = off >> 3, row = off & 7;
        u.pm = 8 * (xcd >> 1) + row;
        u.pn = (xcd & 1) ? (ci == 0 ? 19 : (ci < 9 ? 19 + ci : (ci < 17 ? 27 + ci : (ci < 20 ? 16 + ci : 10 + ci)))) : (ci < 19 ? ci : (ci == 19 ? 32 : 8 + ci));
        return true;
    }
    __device__ __forceinline__ void a_ready(const Unit&) const {}
    __device__ __forceinline__ void done(const Unit& u) const {
        if (u.tag) {
            asm volatile("s_waitcnt vmcnt(0)" ::: "memory");
            if ((threadIdx.x & 63) == 0) __hip_atomic_fetch_add(u.tag == 1 ? early : early + 64, 1u, __ATOMIC_RELAXED, __HIP_MEMORY_SCOPE_AGENT);
        }
    }
};
template <class Epi, class Sched, bool ALIGN_EPI = false, bool SP2 = false>
__device__ __forceinline__ void gemm_phase(PG8_LAS unsigned char* lds, const Gemm g, const Sched& S, const Epi& E) {
    const int tid = threadIdx.x, wid = __builtin_amdgcn_readfirstlane(tid >> 6), lane = tid & 63, wr = wid >> 2, wc = wid & 3, fr = lane & 15, fq = lane >> 4;
    const int K = g.K, nt = K / BK;
    unsigned voffA[2], voffB[2];
#pragma unroll
    for (int i = 0; i < 2; ++i) { int R, C; stage_rc(tid * 16 + i * 8192, R, C); const int Rb = Epi::PERM ? ((R & ~31) + perm32(R & 31)) : R;
        voffA[i] = (unsigned)(R * K + C) * 2u; voffB[i] = (unsigned)(Rb * K + C) * 2u; }
    const size_t kstep = (size_t)(BK * 2);
    const size_t hstep = (size_t)HALF * K * 2;
    const size_t tstep = 2 * hstep;
    const unsigned ldsw = (unsigned)wid * 1024u;
    const int aoff = lds_byte(wr * 64 + fr, fq * 8), boff = lds_byte(wc * 32 + fr, fq * 8);
#define PG8_SA(b, h) (((b) * 2 + (h)) * HTB)
#define PG8_SB(b, h) ((4 + (b) * 2 + (h)) * HTB)
#define PG8_STAGE(bufoff, gbase, voff) do { _Pragma("unroll") for (int _i = 0; _i < 2; ++_i) \
        __builtin_amdgcn_global_load_lds((const unsigned*)((const char*)(gbase) + (voff)[_i]), (PG8_LAS unsigned*)(lds + (bufoff) + ldsw + _i * 8192), 16, 0, 0); } while (0)
#define PG8_LDA(dst, b, h) do { _Pragma("unroll") for (int m = 0; m < 4; ++m) _Pragma("unroll") for (int k = 0; k < 2; ++k) dst[m][k] = *(const PG8_LAS bf16x8*)(lds + PG8_SA(b, h) + aoff + m * 2048 + k * 1024); } while (0)
#define PG8_LDB(dst, b, h) do { _Pragma("unroll") for (int n = 0; n < 2; ++n) _Pragma("unroll") for (int k = 0; k < 2; ++k) dst[n][k] = *(const PG8_LAS bf16x8*)(lds + PG8_SB(b, h) + boff + n * 2048 + k * 1024); } while (0)
#define PG8_MMA(ai, bj, At, Bt) do { __builtin_amdgcn_s_setprio(1); _Pragma("unroll") for (int m = 0; m < 4; ++m) _Pragma("unroll") for (int n = 0; n < 2; ++n) _Pragma("unroll") for (int k = 0; k < 2; ++k) \
        acc[ai][bj][m][n] = __builtin_amdgcn_mfma_f32_16x16x32_bf16(Bt[n][k], At[m][k], acc[ai][bj][m][n], 0, 0, 0); __builtin_amdgcn_s_setprio(0); } while (0)
#define PG8_WAIT_V(n) asm volatile("s_waitcnt vmcnt(" #n ")" ::: "memory")
#define PG8_WAIT_L(n) asm volatile("s_waitcnt lgkmcnt(" #n ")" ::: "memory")
#define PG8_BAR __builtin_amdgcn_s_barrier()
#define PG8_SCHED __builtin_amdgcn_sched_barrier(0)
    Unit cur, nxt; int ui = 0;
    if (!S.next(0, cur)) return;
    f32x4 acc[2][2][4][2];
#pragma unroll
    for (int a = 0; a < 2; ++a)
#pragma unroll
        for (int b = 0; b < 2; ++b)
#pragma unroll
            for (int m = 0; m < 4; ++m)
#pragma unroll
                for (int n = 0; n < 2; ++n) acc[a][b][m][n] = (f32x4){0.f, 0.f, 0.f, 0.f};
    bf16x8 At[4][2], B0[2][2], B1[2][2];
    const char* cA = (const char*)g.A + (size_t)cur.pm * tstep; const char* cB = (const char*)g.Bt + (size_t)cur.pn * tstep;
    S.a_ready(cur);
    if constexpr (SP2) {
        PG8_STAGE(PG8_SB(0, 0), cB, voffB); PG8_STAGE(PG8_SB(0, 1), cB + hstep, voffB); PG8_STAGE(PG8_SA(0, 0), cA, voffA); PG8_STAGE(PG8_SA(0, 1), cA + hstep, voffA);
        if (wr == 1) PG8_BAR;
        PG8_WAIT_V(2); PG8_BAR;
        PG8_STAGE(PG8_SB(1, 0), cB + kstep, voffB); PG8_STAGE(PG8_SA(1, 0), cA + kstep, voffA); PG8_STAGE(PG8_SB(1, 1), cB + hstep + kstep, voffB);
        PG8_WAIT_V(6); PG8_BAR;
    } else {
        PG8_STAGE(PG8_SB(0, 0), cB, voffB); PG8_STAGE(PG8_SA(0, 0), cA, voffA); PG8_STAGE(PG8_SB(0, 1), cB + hstep, voffB); PG8_STAGE(PG8_SA(0, 1), cA + hstep, voffA);
        if (wr == 1) PG8_BAR;
        PG8_WAIT_V(4); PG8_BAR;
        PG8_STAGE(PG8_SB(1, 0), cB + kstep, voffB); PG8_STAGE(PG8_SA(1, 0), cA + kstep, voffA); PG8_STAGE(PG8_SB(1, 1), cB + hstep + kstep, voffB);
        PG8_WAIT_V(6); PG8_BAR;
    }
    for (;;) {
        const bool has_next = S.next(ui + 1, nxt);
        const char* nA = has_next ? (const char*)g.A + (size_t)nxt.pm * tstep : cA; const char* nB = has_next ? (const char*)g.Bt + (size_t)nxt.pn * tstep : cB;
        for (int t = 0; t < nt; t += 2) {
            const bool last = (t == nt - 2);
            const char* a1 = cA + (size_t)(t + 1) * kstep;
            const char* a2 = last ? nA : cA + (size_t)(t + 2) * kstep; const char* b2 = last ? nB : cB + (size_t)(t + 2) * kstep;
            const char* a3 = a2 + kstep; const char* b3 = b2 + kstep;
            if (last && has_next) S.a_ready(nxt);
            if constexpr (SP2) {
            PG8_LDB(B0, 0, 0); PG8_LDB(B1, 0, 1); PG8_SCHED; PG8_LDA(At, 0, 0); PG8_STAGE(PG8_SA(1, 1), a1 + hstep, voffA);
            PG8_WAIT_V(8); PG8_WAIT_L(0); PG8_BAR; PG8_MMA(0, 0, At, B0); PG8_MMA(0, 1, At, B1); PG8_BAR; PG8_SCHED;
            PG8_LDA(At, 0, 1); PG8_STAGE(PG8_SB(0, 0), b2, voffB); PG8_STAGE(PG8_SB(0, 1), b2 + hstep, voffB); PG8_STAGE(PG8_SA(0, 0), a2, voffA);
            PG8_WAIT_V(8); PG8_WAIT_L(0); PG8_BAR; PG8_MMA(1, 0, At, B0); PG8_MMA(1, 1, At, B1); PG8_BAR; PG8_SCHED;
            PG8_LDB(B0, 1, 0); PG8_LDB(B1, 1, 1); PG8_SCHED; PG8_LDA(At, 1, 0); PG8_STAGE(PG8_SA(0, 1), a2 + hstep, voffA);
            PG8_WAIT_V(8); PG8_WAIT_L(0); PG8_BAR; PG8_MMA(0, 0, At, B0); PG8_MMA(0, 1, At, B1); PG8_BAR; PG8_SCHED;
            PG8_LDA(At, 1, 1); PG8_STAGE(PG8_SB(1, 0), b3, voffB); PG8_STAGE(PG8_SB(1, 1), b3 + hstep, voffB); PG8_STAGE(PG8_SA(1, 0), a3, voffA);
            PG8_WAIT_V(8); PG8_WAIT_L(0); PG8_BAR; PG8_MMA(1, 0, At, B0); PG8_MMA(1, 1, At, B1); PG8_BAR; PG8_SCHED;
            } else {
            PG8_LDB(B0, 0, 0); PG8_SCHED; PG8_LDA(At, 0, 0); PG8_STAGE(PG8_SA(1, 1), a1 + hstep, voffA);
            PG8_WAIT_L(8); PG8_BAR; PG8_WAIT_L(0); PG8_MMA(0, 0, At, B0); PG8_BAR; PG8_SCHED;
            PG8_LDB(B1, 0, 1); PG8_STAGE(PG8_SB(0, 0), b2, voffB);
            PG8_BAR; PG8_WAIT_L(0); PG8_MMA(0, 1, At, B1); PG8_BAR;
            PG8_LDA(At, 0, 1); PG8_STAGE(PG8_SA(0, 0), a2, voffA);
            PG8_BAR; PG8_WAIT_L(0); PG8_MMA(1, 0, At, B0); PG8_BAR; PG8_SCHED;
            PG8_STAGE(PG8_SB(0, 1), b2 + hstep, voffB);
            PG8_WAIT_V(6); PG8_BAR; PG8_MMA(1, 1, At, B1); PG8_BAR;
            PG8_LDB(B0, 1, 0); PG8_SCHED; PG8_LDA(At, 1, 0); PG8_STAGE(PG8_SA(0, 1), a2 + hstep, voffA);
            PG8_WAIT_L(8); PG8_BAR; PG8_WAIT_L(0); PG8_MMA(0, 0, At, B0); PG8_BAR; PG8_SCHED;
            PG8_LDB(B1, 1, 1); PG8_STAGE(PG8_SB(1, 0), b3, voffB);
            PG8_BAR; PG8_WAIT_L(0); PG8_MMA(0, 1, At, B1); PG8_BAR;
            PG8_LDA(At, 1, 1); PG8_STAGE(PG8_SA(1, 0), a3, voffA);
            PG8_BAR; PG8_WAIT_L(0); PG8_MMA(1, 0, At, B0); PG8_BAR; PG8_SCHED;
            PG8_STAGE(PG8_SB(1, 1), b3 + hstep, voffB);
            PG8_WAIT_V(6); PG8_BAR; PG8_MMA(1, 1, At, B1); PG8_BAR;
            }
        }
        if constexpr (ALIGN_EPI) { if (wr == 0) PG8_BAR; }
        if constexpr (!Epi::AFTER_DRAIN) { E(acc, cur, wr, wc, fr, fq); S.done(cur); }
        if (!has_next) break;
#pragma unroll
        for (int a = 0; a < 2; ++a)
#pragma unroll
            for (int b = 0; b < 2; ++b)
#pragma unroll
                for (int m = 0; m < 4; ++m)
#pragma unroll
                    for (int n = 0; n < 2; ++n) acc[a][b][m][n] = (f32x4){0.f, 0.f, 0.f, 0.f};
        cur = nxt; cA = nA; cB = nB; ++ui;
        if constexpr (ALIGN_EPI) { if (wr == 1) PG8_BAR; }
    }
    PG8_WAIT_V(0);
    if constexpr (!ALIGN_EPI) { if (wr == 0) PG8_BAR; }
    PG8_BAR;
    if constexpr (Epi::AFTER_DRAIN) { E.fused(acc, cur, wr, wc, fr, fq, lds, wid, lane); S.done(cur); }
#undef PG8_SA
#undef PG8_SB
#undef PG8_STAGE
#undef PG8_LDA
#undef PG8_LDB
#undef PG8_MMA
#undef PG8_WAIT_V
#undef PG8_WAIT_L
#undef PG8_BAR
#undef PG8_SCHED
}
}
#define GAS __attribute__((address_space(1)))
#define LAS __attribute__((address_space(3)))
typedef unsigned short bf16;
typedef unsigned v4u __attribute__((ext_vector_type(4)));
typedef float f32x4 __attribute__((ext_vector_type(4)));
typedef short bf16x8 __attribute__((ext_vector_type(8)));
typedef GAS unsigned gu32;
typedef GAS unsigned long long gu64;
#define RLX_AGENT __ATOMIC_RELAXED, __HIP_MEMORY_SCOPE_AGENT
#define LDS_WAIT() asm volatile("s_waitcnt lgkmcnt(0)" ::: "memory")
#define VM_WAIT() asm volatile("s_waitcnt vmcnt(0)" ::: "memory")
__device__ __forceinline__ unsigned long long rt() { return __builtin_amdgcn_s_memrealtime(); }
__device__ __forceinline__ unsigned f2bf(float f) { unsigned u = __builtin_bit_cast(unsigned, f); return (u + 0x7fffu + ((u >> 16) & 1u)) >> 16; }
__device__ __forceinline__ unsigned pk2(float lo, float hi) { return f2bf(lo) | (f2bf(hi) << 16); }

#define XB_TMO      128
#define XB_XCNT(j)  (256  + 64 * (j))
#define XB_XSUB(j)  (1280 + 64 * (j))
#define XB_XGEN(j)  (2304 + 64 * (j))
#define XB_TOP      3328
#define XB_TOPGEN   3392
#define XCD_BAR_WORDS 3456
#define XB_SPIN_CAP (1u << 18)

__device__ __forceinline__ unsigned xb_ld(unsigned* p)              { return __hip_atomic_load(p, __ATOMIC_RELAXED, __HIP_MEMORY_SCOPE_AGENT); }
__device__ __forceinline__ unsigned xb_add(unsigned* p, unsigned v) { return __hip_atomic_fetch_add(p, v, __ATOMIC_RELAXED, __HIP_MEMORY_SCOPE_AGENT); }
__device__ __forceinline__ unsigned xb_xcc_id() { return (unsigned)__builtin_amdgcn_s_getreg((3 << 11) | 20) & 0xFu; }
#define XB_SPIN(cond, bar) do { unsigned _sp = 0; while (cond) { __builtin_amdgcn_s_sleep(1); \
    if ((++_sp & 255u) == 0u) { if (xb_ld(&(bar)[XB_TMO])) break; if (_sp > XB_SPIN_CAP) { atomicAdd(&(bar)[XB_TMO], 1u); break; } } } } while (0)

struct XcdBarrier {
    unsigned* bar; unsigned x;
    volatile LAS unsigned* st;
};

__device__ __forceinline__ XcdBarrier xcd_barrier_post(unsigned* bar, volatile LAS unsigned* st) {
    XcdBarrier b; b.bar = bar; b.x = xb_xcc_id(); b.st = st;
    if (threadIdx.x == 0) (void)xb_add(&bar[XB_XCNT(b.x)], 1u);
    return b;
}
__device__ __forceinline__ void xcd_barrier_complete(unsigned* bar, unsigned x, unsigned& nloc, unsigned& nx) {
    const unsigned G = gridDim.x * gridDim.y * gridDim.z;
    unsigned sum, cnt, mine, sp = 0u;
    for (;;) {
        sum = 0u; cnt = 0u; mine = 0u;
#pragma unroll
        for (unsigned j = 0; j < 16; ++j) { const unsigned c = xb_ld(&bar[XB_XCNT(j)]); sum += c; cnt += (c > 0u) ? 1u : 0u; mine = (j == x) ? c : mine; }
        if (sum == G) break;
        __builtin_amdgcn_s_sleep(1);
        if ((++sp & 255u) == 0u) { if (xb_ld(&bar[XB_TMO])) break; if (sp > XB_SPIN_CAP) { atomicAdd(&bar[XB_TMO], 1u); break; } }
    }
    nloc = mine > 0u ? mine : 1u; nx = cnt > 0u ? cnt : 1u;
}

__device__ __forceinline__ void xcd_barrier(const XcdBarrier& b) {
    asm volatile("s_waitcnt vmcnt(0)" ::: "memory");
    __syncthreads();
    if (threadIdx.x == 0) {
        unsigned* bar = b.bar;
        __builtin_amdgcn_s_waitcnt(0);
        unsigned nloc = b.st[0], nx = b.st[1];
        if (nloc == 0u) { xcd_barrier_complete(bar, b.x, nloc, nx); b.st[0] = nloc; b.st[1] = nx; }
        const unsigned old = xb_add(&bar[XB_XSUB(b.x)], 1u);
        const unsigned gen = old / nloc;
        if (old + 1u == (gen + 1u) * nloc) {
            __builtin_amdgcn_fence(__ATOMIC_RELEASE, "agent");
            asm volatile("s_waitcnt vmcnt(0)" ::: "memory");
            const unsigned og = xb_add(&bar[XB_TOP], 1u);
            const unsigned tg = og / nx;
            if (og + 1u == (tg + 1u) * nx) xb_add(&bar[XB_TOPGEN], 1u);
            else XB_SPIN(xb_ld(&bar[XB_TOPGEN]) == tg, bar);
            __builtin_amdgcn_fence(__ATOMIC_ACQUIRE, "agent");
            xb_add(&bar[XB_XGEN(b.x)], 1u);
            asm volatile("s_waitcnt vmcnt(0)" ::: "memory");
        } else {
            XB_SPIN(xb_ld(&bar[XB_XGEN(b.x)]) == gen, bar);
            __builtin_amdgcn_fence(__ATOMIC_ACQUIRE, "agent");
            asm volatile("s_waitcnt vmcnt(0)" ::: "memory");
        }
    }
    __syncthreads();
}
constexpr int NWAVES = 8;
constexpr int DM = 4096, SEQ = 4096, MROWS = 8192, MEMROWS = 512;
constexpr int INW = 11272;
constexpr int NPROJ = 11264;
constexpr int C_AQ = 0, C_AK = 2048, C_AV = 2560, C_AZ = 3072, C_MQ = 5120, C_MK = 5632, C_MV = 6144, C_MO = 7168, C_MZ = 8192, C_CQ = 9216, C_CZ = 10240;
constexpr float LN_EPS = 1e-5f, HEAD_NORM_EPS = 1e-6f;
constexpr float DEEPNORM_ALPHA = 1.189207115002721f;

constexpr size_t MiB = 1u << 20;
constexpr size_t WS_CTL = 0, CTL_ZERO_BYTES = 32768;
constexpr size_t WS_ACAT = 2 * MiB;
constexpr size_t WS_BTCAT = 70 * MiB;
constexpr size_t WS_WOT = 174 * MiB;
constexpr size_t WS_PROJ = 206 * MiB;
constexpr size_t WS_MKV = 382 * MiB;
constexpr size_t WS_GATES = 384 * MiB;
constexpr size_t WS_MQK = 385 * MiB;
constexpr size_t WS_CLOC = 401 * MiB;
constexpr size_t WS_CPREV = 435 * MiB;
constexpr size_t WS_SMALL = 452 * MiB;
constexpr size_t WS_MIX = 453 * MiB;
constexpr size_t WS_Y = 517 * MiB;
constexpr size_t WS_END = 581 * MiB;
constexpr int CW_BAR = 4096;
constexpr int CW_EARLY = 64, CW_LATE = 128  , CW_QHEAD = 192, CW_CLOCDONE = 256, CW_SCANDONE = 320;

constexpr int LDS_BYTES = 163840;
constexpr int MISC_OFF = LDS_BYTES - 256;

typedef unsigned v2u __attribute__((ext_vector_type(2)));
#define CAS __attribute__((address_space(4)))
struct Frame {
    LAS unsigned char* lds;
    volatile LAS unsigned* MISC;
    gu32* ctl;
    unsigned char* ws;
    const CAS unsigned char* kargs;
    int tid, lane, wave, G, vcu;
};
__device__ __forceinline__ const float* in_ptr(const Frame& F, int i) { const CAS unsigned char* p = F.kargs; asm volatile("" : "+s"(p)); return *(const float* const CAS*)(p + 8 * i); }
__device__ __forceinline__ float* out_ptr(const Frame& F) { const CAS unsigned char* p = F.kargs; asm volatile("" : "+s"(p)); return *(float* const CAS*)(p + 8 * 14); }
#define WSP(T, off) ((T*)(F.ws + (off)))
#ifdef PROBE_A
#define ISTAMP(k) do { __syncthreads(); if (F.tid == 0) F.MISC[20 + (k)] = (unsigned)__builtin_amdgcn_s_memrealtime(); __syncthreads(); } while (0)
#else
#define ISTAMP(k) do { } while (0)
#endif
__device__ __forceinline__ float bf2f(unsigned h) { return __builtin_bit_cast(float, h << 16); }
__device__ __forceinline__ float wave_sum(float v) {
#pragma unroll
    for (int o = 1; o < 64; o <<= 1) v += __shfl_xor(v, o);
    return v;
}
__device__ __forceinline__ float quad_max(float v) { v = fmaxf(v, __shfl_xor(v, 16)); v = fmaxf(v, __shfl_xor(v, 32)); return v; }
__device__ __forceinline__ float quad_sum(float v) { v += __shfl_xor(v, 16); v += __shfl_xor(v, 32); return v; }
__device__ __forceinline__ float row16_sum(float v) { v += __shfl_xor(v, 1); v += __shfl_xor(v, 2); v += __shfl_xor(v, 4); v += __shfl_xor(v, 8); return v; }
__device__ __forceinline__ float fast_exp(float v) { return __builtin_amdgcn_exp2f(1.4426950408889634f * v); }
__device__ __forceinline__ float sigmoidf_(float v) { return __builtin_amdgcn_rcpf(1.0f + fast_exp(-v)); }
__device__ __forceinline__ bf16x8 mk_frag(unsigned a, unsigned b, unsigned c, unsigned d) { v4u t; t.x = a; t.y = b; t.z = c; t.w = d; return __builtin_bit_cast(bf16x8, t); }
__device__ __forceinline__ bf16x8 ld_frag16(const LAS unsigned char* p) { return *(const LAS bf16x8*)p; }
__device__ __forceinline__ bf16x8 ld_frag8x2(const LAS unsigned char* p0, const LAS unsigned char* p1) {
    const v2u a = *(const LAS v2u*)p0, b = *(const LAS v2u*)p1; return mk_frag(a.x, a.y, b.x, b.y); }
#define MFMA16(a, b, c) __builtin_amdgcn_mfma_f32_16x16x32_bf16((a), (b), (c), 0, 0, 0)

__device__ __forceinline__ void stage_transposed(const bf16* src, size_t spitch, int nrows, int nch, LAS unsigned short* dst, int dpitch, const LAS float* rowscale, int tid) {
    for (int idx = tid; idx < nrows * nch; idx += NWAVES * 64) {
        const int row = idx & (nrows - 1), ch = idx / nrows;
        const v4u q = *(const GAS v4u*)(src + (size_t)row * spitch + ch * 8);
        unsigned e[8] = {q.x & 0xffffu, q.x >> 16, q.y & 0xffffu, q.y >> 16, q.z & 0xffffu, q.z >> 16, q.w & 0xffffu, q.w >> 16};
        LAS unsigned short* d = dst + (ch * 8) * dpitch + row;
        if (rowscale) { const float s = rowscale[row];
#pragma unroll
            for (int j = 0; j < 8; ++j) d[j * dpitch] = (unsigned short)f2bf(bf2f(e[j]) * s); }
        else {
#pragma unroll
            for (int j = 0; j < 8; ++j) d[j * dpitch] = (unsigned short)e[j]; }
    }
}

__device__ __forceinline__ void p0_transpose_item(const float* W, int ldw, bf16* WT, int row_off, LAS float* scr, int kb, int nb, int lane) {
    const int k0 = 64 * kb, n0 = 32 * nb;
    {   const int r8 = lane >> 3, cq = lane & 7;
        f32x4 t[8];
#pragma unroll
        for (int i = 0; i < 8; ++i) t[i] = *(const GAS f32x4*)(W + (size_t)(k0 + 8 * i + r8) * ldw + n0 + 4 * cq);
#pragma unroll
        for (int i = 0; i < 8; ++i) { LAS float* d = scr + (8 * i + r8) * 33 + 4 * cq; d[0] = t[i].x; d[1] = t[i].y; d[2] = t[i].z; d[3] = t[i].w; } }
    LDS_WAIT(); asm volatile("" ::: "memory");
    const int c = lane & 7;
#pragma unroll
    for (int j = 0; j < 4; ++j) { const int n = (lane >> 3) + 8 * j; const LAS float* s = scr + (8 * c) * 33 + n;
        v4u o; o.x = pk2(s[0 * 33], s[1 * 33]); o.y = pk2(s[2 * 33], s[3 * 33]); o.z = pk2(s[4 * 33], s[5 * 33]); o.w = pk2(s[6 * 33], s[7 * 33]);
        *(GAS v4u*)(WT + (size_t)(row_off + n0 + n) * DM + k0 + 8 * c) = o; }
    LDS_WAIT(); asm volatile("" ::: "memory");
}
__device__ __forceinline__ void wout_item(Frame& F, int item) {
    const float* w_out = in_ptr(F, 11); bf16* WOT = WSP(bf16, WS_WOT);
    LAS float* scr = (LAS float*)(F.lds + F.wave * 16384);
    for (int j = 0; j < 8; ++j) { const int r = item * 64 + j * 8 + F.wave; p0_transpose_item(w_out, DM, WOT, 0, scr, r / 128, r % 128, F.lane); }
    __syncthreads();
}
typedef __bf16 bf16x2_t __attribute__((ext_vector_type(2)));
__device__ __forceinline__ float dot2_bf16(unsigned w, unsigned x, float acc) { return __builtin_amdgcn_fdot2_f32_bf16(__builtin_bit_cast(bf16x2_t, w), __builtin_bit_cast(bf16x2_t, x), acc, false); }
__device__ __forceinline__ void p0_prologue(Frame& F) {
    const float* x = in_ptr(F, 0); const float* mem = in_ptr(F, 1); const float* w_in = in_ptr(F, 2); const float* b_i = in_ptr(F, 5); const float* b_f = in_ptr(F, 6); const float* w_mem_kv = in_ptr(F, 10); bf16* ACAT = WSP(bf16, WS_ACAT); bf16* BTCAT = WSP(bf16, WS_BTCAT); float* GATES = WSP(float, WS_GATES);
    const int gw = F.vcu * NWAVES + F.wave, NGW = F.G * NWAVES;
    LAS float* scr = (LAS float*)(F.lds + F.wave * 8448);
    LAS unsigned short* GW = (LAS unsigned short*)(F.lds + 67584);
    {   f32x4 ga[8], gb[8];
#pragma unroll
        for (int i = 0; i < 8; ++i) { const GAS f32x4* p = (const GAS f32x4*)(w_in + (size_t)(F.tid + 512 * i) * INW + 7168); ga[i] = p[0]; gb[i] = p[1]; }
#pragma unroll
        for (int i = 0; i < 8; ++i) { const int k = F.tid + 512 * i;
            GW[0 * DM + k] = (unsigned short)f2bf(ga[i].x); GW[1 * DM + k] = (unsigned short)f2bf(ga[i].y); GW[2 * DM + k] = (unsigned short)f2bf(ga[i].z); GW[3 * DM + k] = (unsigned short)f2bf(ga[i].w);
            GW[4 * DM + k] = (unsigned short)f2bf(gb[i].x); GW[5 * DM + k] = (unsigned short)f2bf(gb[i].y); GW[6 * DM + k] = (unsigned short)f2bf(gb[i].z); GW[7 * DM + k] = (unsigned short)f2bf(gb[i].w); } }
    __syncthreads();
    const float gate_bias = (F.lane < 4) ? b_i[F.lane] : ((F.lane < 8) ? b_f[F.lane - 4] : 0.f);
    constexpr int I0 = 64 * 224, I1 = 64 * 128, I2 = 64 * 64, NITEMS = I0 + I1 + I2;
    int it = gw;
#define P0_ITEMS(n) do { _Pragma("unroll 1") for (int c_ = 0; c_ < (n) && it < NITEMS; ++c_, it += NGW) { int r = it; \
        if (r < I0) p0_transpose_item(w_in, INW, BTCAT, 0, scr, r / 224, r % 224, F.lane); \
        else if ((r -= I0) < I1) p0_transpose_item(w_in + 7176, INW, BTCAT, 7168, scr, r / 128, r % 128, F.lane); \
        else { r -= I1; p0_transpose_item(w_mem_kv, 2048, BTCAT, 11264, scr, r / 64, r % 64, F.lane); } } } while (0)
#pragma unroll 1
    for (int m = gw; m < MROWS + MEMROWS; m += NGW) {
        const bool isx = m < MROWS;
        const GAS f32x4* xr = (const GAS f32x4*)((isx ? x : mem) + (size_t)(isx ? m : m - MROWS) * DM) + F.lane;
        f32x4 v[16];
#pragma unroll
        for (int j = 0; j < 16; ++j) v[j] = xr[64 * j];
        P0_ITEMS(3);
        GAS v2u* o8 = (GAS v2u*)(ACAT + (size_t)m * DM) + F.lane;
        v2u xp[16];
#pragma unroll
        for (int j = 0; j < 16; ++j) { xp[j].x = pk2(v[j].x, v[j].y); xp[j].y = pk2(v[j].z, v[j].w); o8[64 * j] = xp[j]; }
        if (isx) {
            float res = 0.f;
#pragma unroll 1
            for (int g = 0; g < 8; ++g) { float a0 = 0.f, a1 = 0.f;
#pragma unroll
                for (int j = 0; j < 16; ++j) { const v2u w = *(const LAS v2u*)(GW + g * DM + 256 * j + 4 * F.lane); a0 = dot2_bf16(w.x, xp[j].x, a0); a1 = dot2_bf16(w.y, xp[j].y, a1); }
                a0 = wave_sum(a0 + a1); res = (F.lane == g) ? a0 : res; }
            if (F.lane < 8) GATES[(size_t)m * 8 + F.lane] = res + gate_bias;
        }
    }
    P0_ITEMS(1 << 30);
#undef P0_ITEMS
}

__device__ __forceinline__ float log_sigmoid_f(float v) { return fminf(v, 0.f) - log1pf(expf(-fabsf(v))); }
template <int OP> __device__ __forceinline__ void wave_scan128(const LAS float* in, LAS float* out, int lane) {
    const float e0 = in[2 * lane], e1 = in[2 * lane + 1];
    float s = OP ? fmaxf(e0, e1) : (e0 + e1);
#pragma unroll
    for (int o = 1; o < 64; o <<= 1) { const float t = __shfl_up(s, o); if (lane >= o) s = OP ? fmaxf(s, t) : (s + t); }
    float ex = __shfl_up(s, 1);
    if (OP) { const float a = (lane == 0) ? e0 : fmaxf(ex, e0); out[2 * lane] = a; out[2 * lane + 1] = fmaxf(a, e1); }
    else { const float a = (lane == 0) ? e0 : (ex + e0); out[2 * lane] = a; out[2 * lane + 1] = a + e1; }
}

typedef short s16x4 __attribute__((ext_vector_type(4)));
__device__ __forceinline__ s16x4 ds_tr(const LAS unsigned char* p) { return __builtin_bit_cast(s16x4, __builtin_amdgcn_ds_read_tr16_b64_v4i16((LAS s16x4*)p)); }
__device__ __forceinline__ bf16x8 tr_frag(const LAS unsigned char* p0, const LAS unsigned char* p1) { const s16x4 a = ds_tr(p0), b = ds_tr(p1); return __builtin_shufflevector(a, b, 0, 1, 2, 3, 4, 5, 6, 7); }
__device__ __forceinline__ v4u ldg16(const bf16* p) { return *(const GAS v4u*)p; }
__device__ __forceinline__ void stg16(bf16* p, v4u v) { *(GAS v4u*)p = v; }
__device__ __forceinline__ void ws_store16_sc1(const Frame& F, size_t off, v4u v) {
    const __amdgpu_buffer_rsrc_t rsrc = __builtin_amdgcn_make_buffer_rsrc(F.ws, 0, (unsigned)WS_END, 0x00020000);
    __builtin_amdgcn_raw_buffer_store_b128(v, rsrc, (unsigned)off, 0, 16); }
__device__ __forceinline__ v4u zero4() { v4u z; z.x = 0u; z.y = 0u; z.z = 0u; z.w = 0u; return z; }
__device__ __forceinline__ v4u gate_pack(f32x4 a, f32x4 b, float s, v4u z) {
    v4u o;
    o.x = pg8::cvt_pk_bf16(a[0] * s * bf2f(z.x & 0xffffu), a[1] * s * bf2f(z.x >> 16)); o.y = pg8::cvt_pk_bf16(a[2] * s * bf2f(z.y & 0xffffu), a[3] * s * bf2f(z.y >> 16));
    o.z = pg8::cvt_pk_bf16(b[0] * s * bf2f(z.z & 0xffffu), b[1] * s * bf2f(z.z >> 16)); o.w = pg8::cvt_pk_bf16(b[2] * s * bf2f(z.w & 0xffffu), b[3] * s * bf2f(z.w >> 16));
    return o;
}

__device__ __forceinline__ void scan_item(Frame& F, int sl) {
    float* CLOC = WSP(float, WS_CLOC); float* CST = WSP(float, WS_SMALL); float* MPREV = WSP(float, WS_SMALL + 4096);
    const int gt = sl * (NWAVES * 64) + F.tid;
    constexpr int OCT = 257 * 16;
    if (gt < 8 * OCT) {
        const int bh = gt / OCT, off = (gt % OCT) * 8;
        float m = 0.f; f32x4 c0 = {0.f, 0.f, 0.f, 0.f}, c1 = {0.f, 0.f, 0.f, 0.f};
#pragma unroll 8
        for (int c = 0; c < 32; ++c) {
            const int item = bh * 32 + c;
            const float gl = CST[item * 2], ml = CST[item * 2 + 1];
            const GAS f32x4* cp = (const GAS f32x4*)(CLOC + (size_t)item * (257 * 128) + off);
            const f32x4 cl0 = cp[0], cl1 = cp[1];
            v4u o; o.x = pk2(c0[0], c0[1]); o.y = pk2(c0[2], c0[3]); o.z = pk2(c1[0], c1[1]); o.w = pk2(c1[2], c1[3]);
            ws_store16_sc1(F, WS_CPREV + ((size_t)item * (257 * 128) + off) * 2, o);
            if (off == 0) __hip_atomic_store(MPREV + item, m, RLX_AGENT);
            const float mn = fmaxf(gl + m, ml), sp = expf(gl + m - mn), sl2 = expf(ml - mn);
            c0 = c0 * sp + cl0 * sl2; c1 = c1 * sp + cl1 * sl2; m = mn;
        }
    }
    asm volatile("s_waitcnt vmcnt(0)" ::: "memory");
    __syncthreads();
    if (F.tid == 0) __hip_atomic_fetch_add(F.ctl + CW_SCANDONE, 1u, RLX_AGENT);
}

__device__ __forceinline__ void swa_item4(Frame& F, int item) {
    int tid = F.tid; asm volatile("" : "+v"(tid)); const int lane = tid & 63;
    const float* rel_bias = in_ptr(F, 8); const float* sinks = in_ptr(F, 9); bf16* PROJ = WSP(bf16, WS_PROJ); bf16* MIX = WSP(bf16, WS_MIX);
    const int b = item >> 7, n = (item >> 2) & 31, kv = item & 3;
    const int row0 = b * SEQ + n * 128;
    LAS unsigned char* Ks = F.lds;
    LAS unsigned char* Vs = F.lds + 69632;
    LAS float* BT = (LAS float*)(F.lds + 143360);
    const int g = F.wave >> 1, head = kv * 4 + g, l15 = lane & 15, quad = lane >> 4, tq = (lane & 15) >> 2, tp = lane & 3;
    const int qw = (F.wave & 1) * 64;
    bf16x8 qf[2][2][4];
#pragma unroll
    for (int ds = 0; ds < 2; ++ds)
#pragma unroll
        for (int qt = 0; qt < 2; ++qt) { const bf16* qp = PROJ + (size_t)(row0 + qw + 32 * ds + 16 * qt + l15) * NPROJ + C_AQ + head * 128 + 8 * quad;
#pragma unroll
            for (int ks = 0; ks < 4; ++ks) qf[ds][qt][ks] = __builtin_bit_cast(bf16x8, ldg16(qp + 32 * ks)); }
    {   const int gg = tid >> 7, dist = tid & 127; int bucket = dist;
        if (dist >= 16) { const float ratio = (float)dist / 16.0f; const int lg = 16 + (int)(logf(ratio) / logf(8.0f) * 16.0f); bucket = lg < 31 ? lg : 31; }
        BT[gg * 128 + dist] = rel_bias[bucket * 16 + kv * 4 + gg] * 1.4426950408889634f; }
    {   v4u kq[8], vq[8];
#pragma unroll
        for (int it = 0; it < 8; ++it) { const int idx = tid + 512 * it, key = idx >> 4, ch = idx & 15; const bool valid = (n > 0) || (key >= 128);
            kq[it] = zero4(); vq[it] = zero4();
            if (valid) { const bf16* src = PROJ + (size_t)(row0 - 128 + key) * NPROJ + kv * 128 + ch * 8; kq[it] = ldg16(src + C_AK); vq[it] = ldg16(src + C_AV); } }
#pragma unroll
        for (int it = 0; it < 8; ++it) { const int idx = tid + 512 * it, key = idx >> 4, ch = idx & 15;
            *(LAS v4u*)(Ks + key * 272 + ch * 16) = kq[it]; *(LAS v4u*)(Vs + key * 288 + ch * 16) = vq[it]; } }
    __syncthreads();
    ISTAMP(26);
    const float sink = sinks[head];
    const float scale = 0.08838834764831845f;
#pragma unroll
    for (int ds = 0; ds < 2; ++ds) {
        const int q0 = qw + 32 * ds, kbase = q0;
        v4u zz[2][4];
#pragma unroll
        for (int qt = 0; qt < 2; ++qt) { const bf16* zp = PROJ + (size_t)(row0 + q0 + 16 * qt + l15) * NPROJ + C_AZ + head * 128 + 8 * quad;
#pragma unroll
            for (int P2 = 0; P2 < 4; ++P2) zz[qt][P2] = ldg16(zp + 32 * P2); }
        f32x4 st[2][10];
#pragma unroll
        for (int kt = 0; kt < 10; ++kt) { f32x4 a0 = {0.f, 0.f, 0.f, 0.f}, a1 = {0.f, 0.f, 0.f, 0.f}; const LAS unsigned char* kp = Ks + (kbase + 16 * kt + l15) * 272 + 16 * quad;
#pragma unroll
            for (int ks = 0; ks < 4; ++ks) { const bf16x8 kf = ld_frag16(kp + 64 * ks); a0 = MFMA16(kf, qf[ds][0][ks], a0); a1 = MFMA16(kf, qf[ds][1][ks], a1); }
            st[0][kt] = a0; st[1][kt] = a1; }
        if (ds == 0) ISTAMP(27);
        bf16x8 pb[2][5]; float inv[2];
        const float sc2 = scale * 1.4426950408889634f, sink2 = sink * 1.4426950408889634f;
        const LAS float* btl = BT + g * 128 + l15 - 4 * quad;
#pragma unroll
        for (int qt = 0; qt < 2; ++qt) {
            float mx = sink2;
            if (n > 0) {
#pragma unroll
                for (int kt = 0; kt < 10; ++kt) { const int delta = kt - qt;
                    if (delta < 0 || delta > 8) { st[qt][kt] = (f32x4){-INFINITY, -INFINITY, -INFINITY, -INFINITY}; continue; }
#pragma unroll
                    for (int r = 0; r < 4; ++r) { const int e = l15 - 4 * quad - r;
                        float sv = st[qt][kt][r] * sc2 + btl[128 - 16 * delta - r];
                        if (delta == 0) sv = (e < 0) ? sv : -INFINITY;
                        if (delta == 8) sv = (e >= 0) ? sv : -INFINITY;
                        st[qt][kt][r] = sv; mx = fmaxf(mx, sv); } }
            } else {
                const int qi = q0 + 16 * qt + l15;
#pragma unroll
                for (int kt = 0; kt < 10; ++kt)
#pragma unroll
                    for (int r = 0; r < 4; ++r) { const int si = kbase + 16 * kt + 4 * quad + r, dist = qi + 128 - si;
                        const bool ok = (dist >= 0) && (dist < 128) && (si >= 128);
                        const float sv = ok ? st[qt][kt][r] * sc2 + BT[g * 128 + (dist & 127)] : -INFINITY;
                        st[qt][kt][r] = sv; mx = fmaxf(mx, sv); }
            }
            mx = quad_max(mx);
            float sum = 0.f;
#pragma unroll
            for (int kt = 0; kt < 10; ++kt)
#pragma unroll
                for (int r = 0; r < 4; ++r) { const float p = __builtin_amdgcn_exp2f(st[qt][kt][r] - mx); st[qt][kt][r] = p; sum += p; }
            sum = quad_sum(sum) + __builtin_amdgcn_exp2f(sink2 - mx);
            inv[qt] = 1.0f / sum;
#pragma unroll
            for (int kp = 0; kp < 5; ++kp) { const f32x4 p0 = st[qt][2 * kp], p1 = st[qt][2 * kp + 1];
                pb[qt][kp] = mk_frag(pg8::cvt_pk_bf16(p0[0], p0[1]), pg8::cvt_pk_bf16(p0[2], p0[3]), pg8::cvt_pk_bf16(p1[0], p1[1]), pg8::cvt_pk_bf16(p1[2], p1[3])); }
        }
        if (ds == 0) ISTAMP(28);
        const LAS unsigned char* vb = Vs + (kbase + 4 * quad + tq) * 288 + 16 * tp;
#pragma unroll
        for (int P2 = 0; P2 < 4; ++P2) {
            f32x4 o00 = {0.f, 0.f, 0.f, 0.f}, o01 = o00, o10 = o00, o11 = o00;
#pragma unroll
            for (int kp = 0; kp < 5; ++kp) { const LAS unsigned char* va = vb + (32 * kp) * 288 + 64 * P2;
                const bf16x8 v0 = tr_frag(va, va + 16 * 288), v1 = tr_frag(va + 8, va + 16 * 288 + 8);
                o00 = MFMA16(v0, pb[0][kp], o00); o01 = MFMA16(v1, pb[0][kp], o01);
                o10 = MFMA16(v0, pb[1][kp], o10); o11 = MFMA16(v1, pb[1][kp], o11); }
            bf16* op = MIX + (size_t)(row0 + q0 + l15) * DM + head * 128 + 8 * quad + 32 * P2;
            stg16(op, gate_pack(o00, o01, inv[0], zz[0][P2]));
            stg16(op + (size_t)16 * DM, gate_pack(o10, o11, inv[1], zz[1][P2]));
        }
    }
    __syncthreads();
}

__device__ __forceinline__ void cross_item3(Frame& F, int item) {
    int tid = F.tid; asm volatile("" : "+v"(tid)); const int lane = tid & 63;
    bf16* PROJ = WSP(bf16, WS_PROJ); bf16* MKV = WSP(bf16, WS_MKV); bf16* MIX = WSP(bf16, WS_MIX);
    const int b = item >> 7, h = (item >> 5) & 3, qt = item & 31;
    const int l15 = lane & 15, quad = lane >> 4, tq = (lane & 15) >> 2, tp = lane & 3;
    const size_t grow = (size_t)b * SEQ + qt * 128 + F.wave * 16 + l15;
    const bf16* kvsrc = MKV + (size_t)(b * 256) * 2048 + h * 256;
    bf16x8 qf[8];
    { const bf16* qp = PROJ + grow * NPROJ + C_CQ + h * 256 + 8 * quad;
#pragma unroll
      for (int ks = 0; ks < 8; ++ks) qf[ks] = __builtin_bit_cast(bf16x8, ldg16(qp + 32 * ks)); }
    {   v4u t[16];
#pragma unroll
        for (int it = 0; it < 16; ++it) { const int idx = tid + 512 * it, m = idx >> 5, ch = idx & 31; t[it] = ldg16(kvsrc + (size_t)m * 2048 + ch * 8); }
#pragma unroll
        for (int it = 0; it < 16; ++it) { const int idx = tid + 512 * it, m = idx >> 5, ch = idx & 31; *(LAS v4u*)(F.lds + m * 528 + ch * 16) = t[it]; } }
    __syncthreads();
    v4u vt[16];
#pragma unroll
    for (int it = 0; it < 16; ++it) { const int idx = tid + 512 * it, m = idx >> 5, ch = idx & 31; vt[it] = ldg16(kvsrc + 1024 + (size_t)m * 2048 + ch * 8); }
    bf16x8 pb[8]; float inv;
    {
        f32x4 st[16];
#pragma unroll
        for (int kt = 0; kt < 16; ++kt) { f32x4 a = {0.f, 0.f, 0.f, 0.f}; const LAS unsigned char* kp = F.lds + (16 * kt + l15) * 528 + 16 * quad;
#pragma unroll
            for (int ks = 0; ks < 8; ++ks) a = MFMA16(ld_frag16(kp + 64 * ks), qf[ks], a);
            st[kt] = a; }
        float mx = -INFINITY;
#pragma unroll
        for (int kt = 0; kt < 16; ++kt)
#pragma unroll
            for (int r = 0; r < 4; ++r) { const float sc = st[kt][r] * 0.0625f; st[kt][r] = sc; mx = fmaxf(mx, sc); }
        mx = quad_max(mx);
        float sum = 0.f;
#pragma unroll
        for (int kt = 0; kt < 16; ++kt)
#pragma unroll
            for (int r = 0; r < 4; ++r) { const float p = fast_exp(st[kt][r] - mx); st[kt][r] = p; sum += p; }
        sum = quad_sum(sum);
        inv = 1.0f / sum;
#pragma unroll
        for (int kp = 0; kp < 8; ++kp) { const f32x4 p0 = st[2 * kp], p1 = st[2 * kp + 1];
            pb[kp] = mk_frag(pg8::cvt_pk_bf16(p0[0], p0[1]), pg8::cvt_pk_bf16(p0[2], p0[3]), pg8::cvt_pk_bf16(p1[0], p1[1]), pg8::cvt_pk_bf16(p1[2], p1[3])); }
    }
    __syncthreads();
#pragma unroll
    for (int it = 0; it < 16; ++it) { const int idx = tid + 512 * it, m = idx >> 5, ch = idx & 31; *(LAS v4u*)(F.lds + m * 544 + ch * 16) = vt[it]; }
    const bf16* zp = PROJ + grow * NPROJ + C_CZ + h * 256 + 8 * quad; bf16* op = MIX + grow * DM + 3072 + h * 256 + 8 * quad;
    v4u zz[8];
#pragma unroll
    for (int P2 = 0; P2 < 8; ++P2) zz[P2] = ldg16(zp + 32 * P2);
    __syncthreads();
    const LAS unsigned char* vb = F.lds + (4 * quad + tq) * 544 + 16 * tp;
#pragma unroll
    for (int P2 = 0; P2 < 8; ++P2) {
        f32x4 o0 = {0.f, 0.f, 0.f, 0.f}, o1 = {0.f, 0.f, 0.f, 0.f};
#pragma unroll
        for (int kp = 0; kp < 8; ++kp) { const LAS unsigned char* va = vb + (32 * kp) * 544 + 64 * P2;
            o0 = MFMA16(tr_frag(va, va + 16 * 544), pb[kp], o0);
            o1 = MFMA16(tr_frag(va + 8, va + 16 * 544 + 8), pb[kp], o1); }
        stg16(op + 32 * P2, gate_pack(o0, o1, inv, zz[P2]));
    }
    __syncthreads();
}

__device__ __forceinline__ void conv8(const v4u (&r)[4], const f32x4 (&w)[4][2], const f32x4 (&cb)[2], float oscale, v4u& o) {
    float y[8];
#pragma unroll
    for (int e = 0; e < 8; ++e) y[e] = cb[e >> 2][e & 3];
#pragma unroll
    for (int j = 0; j < 4; ++j) { const unsigned q[4] = {r[j].x, r[j].y, r[j].z, r[j].w};
#pragma unroll
        for (int e = 0; e < 8; ++e) { const float xv = (e & 1) ? bf2f(q[e >> 1] >> 16) : bf2f(q[e >> 1] & 0xffffu); y[e] += w[j][e >> 2][e & 3] * xv; } }
#pragma unroll
    for (int e = 0; e < 8; ++e) y[e] = y[e] * sigmoidf_(y[e]) * oscale;
    o.x = pk2(y[0], y[1]); o.y = pk2(y[2], y[3]); o.z = pk2(y[4], y[5]); o.w = pk2(y[6], y[7]);
}
__device__ __forceinline__ void cloc_item3(Frame& F, int item) {
    int tid = F.tid; asm volatile("" : "+v"(tid)); const int lane = tid & 63;
    const float* conv_w = in_ptr(F, 3); const float* conv_b = in_ptr(F, 4); bf16* PROJ = WSP(bf16, WS_PROJ); float* GATES = WSP(float, WS_GATES); float* CST = WSP(float, WS_SMALL);
    const int b = item >> 7, h = (item >> 5) & 3, c = item & 31;
    const int r0 = b * SEQ + c * 128;
    LAS unsigned char* V = F.lds; LAS unsigned char* KQ = F.lds + 69632;
    LAS float* LI = (LAS float*)(F.lds + 106496); LAS float* LF = LI + 128; LAS float* BB = LF + 128; LAS float* WW = BB + 128;
    {   v4u vt[8];
#pragma unroll
        for (int it = 0; it < 8; ++it) { const int idx = tid + 512 * it, l = idx >> 5, ch = idx & 31; vt[it] = ldg16(PROJ + (size_t)(r0 + l) * NPROJ + C_MV + h * 256 + ch * 8); }
        float li = 0.f, fp = 0.f;
        if (tid < 128) { li = GATES[(size_t)(r0 + tid) * 8 + h]; fp = GATES[(size_t)(r0 + tid) * 8 + 4 + h]; }
#pragma unroll
        for (int it = 0; it < 8; ++it) { const int idx = tid + 512 * it, l = idx >> 5, ch = idx & 31; *(LAS v4u*)(V + l * 544 + ch * 16) = vt[it]; }
        if (tid < 128) { v4u o1 = zero4(); o1.x = 0x3F80u; *(LAS v4u*)(V + tid * 544 + 512) = o1; *(LAS v4u*)(V + tid * 544 + 528) = zero4(); LI[tid] = li; LF[tid] = log_sigmoid_f(fp); }
    }
    __syncthreads();
    if (F.wave == 0) {
        wave_scan128<0>(LF, BB, lane);
        const float gl = __shfl(BB[2 * lane + 1], 63);
        const float a0 = gl - BB[2 * lane] + LI[2 * lane], a1 = gl - BB[2 * lane + 1] + LI[2 * lane + 1];
        float mx = fmaxf(a0, a1);
#pragma unroll
        for (int o = 1; o < 64; o <<= 1) mx = fmaxf(mx, __shfl_xor(mx, o));
        WW[2 * lane] = expf(a0 - mx); WW[2 * lane + 1] = expf(a1 - mx);
        if (lane == 0) { __hip_atomic_store(CST + item * 2, gl, RLX_AGENT); __hip_atomic_store(CST + item * 2 + 1, mx, RLX_AGENT); }
    }
    v4u kpk[4];
    {   const int ch = tid & 15;
        f32x4 wq[4][2], wk[4][2], bq[2], bk[2];
#pragma unroll
        for (int j = 0; j < 4; ++j) { const GAS f32x4* pq = (const GAS f32x4*)(conv_w + j * 1024 + h * 128 + ch * 8); const GAS f32x4* pk = (const GAS f32x4*)(conv_w + j * 1024 + 512 + h * 128 + ch * 8);
            wq[j][0] = pq[0]; wq[j][1] = pq[1]; wk[j][0] = pk[0]; wk[j][1] = pk[1]; }
        { const GAS f32x4* pq = (const GAS f32x4*)(conv_b + h * 128 + ch * 8); const GAS f32x4* pk = (const GAS f32x4*)(conv_b + 512 + h * 128 + ch * 8); bq[0] = pq[0]; bq[1] = pq[1]; bk[0] = pk[0]; bk[1] = pk[1]; }
#pragma unroll
        for (int i = 0; i < 4; ++i) { const int l = (tid >> 4) + 32 * i;
            v4u rq[4], rk[4];
#pragma unroll
            for (int j = 0; j < 4; ++j) { const int rr = l - 3 + j; rq[j] = zero4(); rk[j] = zero4();
                if (c > 0 || rr >= 0) { const bf16* src = PROJ + (size_t)(r0 + rr) * NPROJ + h * 128 + ch * 8; rq[j] = ldg16(src + C_MQ); rk[j] = ldg16(src + C_MK); } }
            v4u oq; conv8(rq, wq, bq, 1.0f, oq); conv8(rk, wk, bk, 0.08838834764831845f, kpk[i]);
            ws_store16_sc1(F, WS_MQK + ((size_t)(r0 + l) * 1024 + h * 128 + ch * 8) * 2, oq);
            ws_store16_sc1(F, WS_MQK + ((size_t)(r0 + l) * 1024 + 512 + h * 128 + ch * 8) * 2, kpk[i]); }
    }
    __syncthreads();
    {   const int ch = tid & 15;
#pragma unroll
        for (int i = 0; i < 4; ++i) { const int l = (tid >> 4) + 32 * i; const float w = WW[l]; const v4u k = kpk[i]; v4u o;
            o.x = pk2(bf2f(k.x & 0xffffu) * w, bf2f(k.x >> 16) * w); o.y = pk2(bf2f(k.y & 0xffffu) * w, bf2f(k.y >> 16) * w);
            o.z = pk2(bf2f(k.z & 0xffffu) * w, bf2f(k.z >> 16) * w); o.w = pk2(bf2f(k.w & 0xffffu) * w, bf2f(k.w >> 16) * w);
            *(LAS v4u*)(KQ + l * 288 + ch * 16) = o; } }
    __syncthreads();
    {   const int l15 = lane & 15, quad = lane >> 4, tq = (lane & 15) >> 2, tp = lane & 3;
        const LAS unsigned char* kb = KQ + (8 * quad + tq) * 288 + 8 * tp;
        const LAS unsigned char* vb = V + (8 * quad + tq) * 544 + 8 * tp;
        for (int vt = F.wave; vt < 17; vt += 8) {
            bf16x8 bfr[4];
#pragma unroll
            for (int ks = 0; ks < 4; ++ks) { const LAS unsigned char* p = vb + (32 * ks) * 544 + 32 * vt; bfr[ks] = tr_frag(p, p + 4 * 544); }
            const int v = 16 * vt + l15;
#pragma unroll
            for (int nt = 0; nt < 8; ++nt) { f32x4 a = {0.f, 0.f, 0.f, 0.f};
#pragma unroll
                for (int ks = 0; ks < 4; ++ks) { const LAS unsigned char* p = kb + (32 * ks) * 288 + 32 * nt; a = MFMA16(tr_frag(p, p + 4 * 288), bfr[ks], a); }
                if (v < 257) ws_store16_sc1(F, WS_CLOC + ((size_t)item * (257 * 128) + (size_t)v * 128 + 16 * nt + 4 * quad) * 4, __builtin_bit_cast(v4u, a)); }
        }
    }
    asm volatile("s_waitcnt vmcnt(0)" ::: "memory");
    __syncthreads();
    if (tid == 0) __hip_atomic_fetch_add(F.ctl + CW_CLOCDONE, 1u, RLX_AGENT);
}

__device__ __forceinline__ void mout_item3(Frame& F, int item) {
    int tid = F.tid; asm volatile("" : "+v"(tid)); const int lane = tid & 63;
    const float* m_norm_g = in_ptr(F, 7); bf16* PROJ = WSP(bf16, WS_PROJ); bf16* MQK = WSP(bf16, WS_MQK); bf16* CPREV = WSP(bf16, WS_CPREV); float* GATES = WSP(float, WS_GATES); float* MPREV = WSP(float, WS_SMALL + 4096); bf16* MIX = WSP(bf16, WS_MIX);
    const int b = item >> 7, h = (item >> 5) & 3, c = item & 31;
    const int r0 = b * SEQ + c * 128;
    LAS unsigned char* V = F.lds; LAS unsigned char* CP = F.lds + 69632;
    LAS float* LI = (LAS float*)(F.lds + 143616); LAS float* LF = LI + 128; LAS float* BB = LF + 128; LAS float* UU = BB + 128; LAS float* MM = UU + 128;
    const float mprev = MPREV[item];
    {   v4u vt[8], ct[9];
#pragma unroll
        for (int it = 0; it < 8; ++it) { const int idx = tid + 512 * it, l = idx >> 5, ch = idx & 31; vt[it] = ldg16(PROJ + (size_t)(r0 + l) * NPROJ + C_MV + h * 256 + ch * 8); }
#pragma unroll
        for (int it = 0; it < 9; ++it) { const int idx = tid + 512 * it, row = idx >> 4, ch = idx & 15; ct[it] = zero4();
            if (row < 257) ct[it] = ldg16(CPREV + (size_t)item * (257 * 128) + row * 128 + ch * 8); }
        float li = 0.f, fp = 0.f;
        if (tid < 128) { li = GATES[(size_t)(r0 + tid) * 8 + h]; fp = GATES[(size_t)(r0 + tid) * 8 + 4 + h]; }
#pragma unroll
        for (int it = 0; it < 8; ++it) { const int idx = tid + 512 * it, l = idx >> 5, ch = idx & 31; *(LAS v4u*)(V + l * 544 + ch * 16) = vt[it]; }
#pragma unroll
        for (int it = 0; it < 9; ++it) { const int idx = tid + 512 * it, row = idx >> 4, ch = idx & 15; if (row < 272) *(LAS v4u*)(CP + row * 272 + ch * 16) = ct[it]; }
        if (tid < 128) { v4u o1 = zero4(); o1.x = 0x3F80u; *(LAS v4u*)(V + tid * 544 + 512) = o1; *(LAS v4u*)(V + tid * 544 + 528) = zero4(); LI[tid] = li; LF[tid] = log_sigmoid_f(fp); }
    }
    __syncthreads();
    const int l15 = lane & 15, quad = lane >> 4, tq = (lane & 15) >> 2, tp = lane & 3, t0 = 16 * F.wave;
    const int t = t0 + l15;
    const size_t grow = (size_t)(r0 + t);
    bf16x8 qf[4], kf[8][4];
    { const bf16* qp = MQK + grow * 1024 + h * 128 + 8 * quad;
#pragma unroll
      for (int ks = 0; ks < 4; ++ks) qf[ks] = __builtin_bit_cast(bf16x8, ldg16(qp + 32 * ks)); }
#pragma unroll
    for (int st = 0; st < 8; ++st) { const bf16* kp = MQK + (size_t)(r0 + 16 * st + l15) * 1024 + 512 + h * 128 + 8 * quad;
#pragma unroll
        for (int ks = 0; ks < 4; ++ks) kf[st][ks] = __builtin_bit_cast(bf16x8, ldg16(kp + 32 * ks)); }
    if (F.wave == 0) {
        wave_scan128<0>(LF, BB, lane);
        UU[2 * lane] = LI[2 * lane] - BB[2 * lane]; UU[2 * lane + 1] = LI[2 * lane + 1] - BB[2 * lane + 1];
        wave_scan128<1>(UU, MM, lane);
        MM[2 * lane] = fmaxf(MM[2 * lane], mprev); MM[2 * lane + 1] = fmaxf(MM[2 * lane + 1], mprev);
    }
    __syncthreads();
    const float Mt = MM[t], mt = BB[t] + Mt;
    bf16x8 sb[4], qb[4];
    {
        f32x4 sT[8];
#pragma unroll
        for (int st = 0; st < 8; ++st) { f32x4 a = {0.f, 0.f, 0.f, 0.f};
#pragma unroll
            for (int ks = 0; ks < 4; ++ks) a = MFMA16(kf[st][ks], qf[ks], a);
#pragma unroll
            for (int r = 0; r < 4; ++r) { const int s = 16 * st + 4 * quad + r; a[r] = (s <= t) ? a[r] * fast_exp(UU[s] - Mt) : 0.f; }
            sT[st] = a; }
#pragma unroll
        for (int kp = 0; kp < 4; ++kp) { const f32x4 p0 = sT[2 * kp], p1 = sT[2 * kp + 1];
            sb[kp] = mk_frag(pg8::cvt_pk_bf16(p0[0], p0[1]), pg8::cvt_pk_bf16(p0[2], p0[3]), pg8::cvt_pk_bf16(p1[0], p1[1]), pg8::cvt_pk_bf16(p1[2], p1[3])); }
        const float wi = fast_exp(mprev - Mt);
#pragma unroll
        for (int ks = 0; ks < 4; ++ks) { const v4u q = __builtin_bit_cast(v4u, qf[ks]);
            qb[ks] = mk_frag(pg8::cvt_pk_bf16(bf2f(q.x & 0xffffu) * wi, bf2f(q.x >> 16) * wi), pg8::cvt_pk_bf16(bf2f(q.y & 0xffffu) * wi, bf2f(q.y >> 16) * wi),
                             pg8::cvt_pk_bf16(bf2f(q.z & 0xffffu) * wi, bf2f(q.z >> 16) * wi), pg8::cvt_pk_bf16(bf2f(q.w & 0xffffu) * wi, bf2f(q.w >> 16) * wi)); }
    }
    const bf16* op = PROJ + grow * NPROJ + C_MO + h * 256 + 8 * quad; const bf16* zp = PROJ + grow * NPROJ + C_MZ + h * 256 + 8 * quad;
    v4u og[8], zz[8];
#pragma unroll
    for (int P2 = 0; P2 < 8; ++P2) { og[P2] = ldg16(op + 32 * P2); zz[P2] = ldg16(zp + 32 * P2); }
    const LAS unsigned char* vb = V + (4 * quad + tq) * 544 + 16 * tp;
    const LAS unsigned char* cb = CP + (8 * (l15 >> 2) + (l15 & 3)) * 272 + 16 * quad;
    f32x4 num[16]; float den;
    {   f32x4 a = {0.f, 0.f, 0.f, 0.f};
        const LAS unsigned char* vd = V + (4 * quad + tq) * 544 + 512 + 8 * tp; const LAS unsigned char* cd = CP + (256 + l15) * 272 + 16 * quad;
#pragma unroll
        for (int kp = 0; kp < 4; ++kp) { const LAS unsigned char* p = vd + (32 * kp) * 544; a = MFMA16(tr_frag(p, p + 16 * 544), sb[kp], a); }
#pragma unroll
        for (int ks = 0; ks < 4; ++ks) a = MFMA16(ld_frag16(cd + 64 * ks), qb[ks], a);
        den = __shfl(a[0], l15); }
#pragma unroll
    for (int P2 = 0; P2 < 8; ++P2)
#pragma unroll
        for (int hf = 0; hf < 2; ++hf) { f32x4 a = {0.f, 0.f, 0.f, 0.f};
#pragma unroll
            for (int kp = 0; kp < 4; ++kp) { const LAS unsigned char* p = vb + (32 * kp) * 544 + 64 * P2 + 8 * hf; a = MFMA16(tr_frag(p, p + 16 * 544), sb[kp], a); }
            const LAS unsigned char* cp = cb + (32 * P2 + 4 * hf) * 272;
#pragma unroll
            for (int ks = 0; ks < 4; ++ks) a = MFMA16(ld_frag16(cp + 64 * ks), qb[ks], a);
            num[2 * P2 + hf] = a; }
    const float inv = 1.0f / fmaxf(fabsf(den), expf(-mt));
    float s = 0.f;
#pragma unroll
    for (int P2 = 0; P2 < 8; ++P2) { const v4u o = og[P2];
        f32x4& a = num[2 * P2]; f32x4& bq = num[2 * P2 + 1];
        a[0] *= inv * bf2f(o.x & 0xffffu); a[1] *= inv * bf2f(o.x >> 16); a[2] *= inv * bf2f(o.y & 0xffffu); a[3] *= inv * bf2f(o.y >> 16);
        bq[0] *= inv * bf2f(o.z & 0xffffu); bq[1] *= inv * bf2f(o.z >> 16); bq[2] *= inv * bf2f(o.w & 0xffffu); bq[3] *= inv * bf2f(o.w >> 16);
        s += (a[0] + a[1]) + (a[2] + a[3]) + (bq[0] + bq[1]) + (bq[2] + bq[3]); }
    const float mean = quad_sum(s) * (1.0f / 256.0f);
    float q2 = 0.f;
#pragma unroll
    for (int i = 0; i < 16; ++i) { num[i] = num[i] - mean; q2 += (num[i][0] * num[i][0] + num[i][1] * num[i][1]) + (num[i][2] * num[i][2] + num[i][3] * num[i][3]); }
    const float rstd = 1.0f / sqrtf(quad_sum(q2) * (1.0f / 256.0f) + HEAD_NORM_EPS);
    const float* ng = m_norm_g + h * 256 + 8 * quad; bf16* mp = MIX + grow * DM + 2048 + h * 256 + 8 * quad;
#pragma unroll
    for (int P2 = 0; P2 < 8; ++P2) {
        const f32x4 g0 = *(const GAS f32x4*)(ng + 32 * P2), g1 = *(const GAS f32x4*)(ng + 32 * P2 + 4);
        stg16(mp + 32 * P2, gate_pack(num[2 * P2] * g0, num[2 * P2 + 1] * g1, rstd, zz[P2])); }
    __syncthreads();
}

__device__ __forceinline__ void ln_phase(Frame& F, float inject) {
    const float* x = in_ptr(F, 0); const float* ln_g = in_ptr(F, 12); const float* ln_b = in_ptr(F, 13); float* out = out_ptr(F); bf16* Y = WSP(bf16, WS_Y);
    const int gw = F.vcu * NWAVES + F.wave, NGW = F.G * NWAVES;
    for (int m = gw; m < MROWS; m += NGW) {
        const GAS f32x4* xr = (const GAS f32x4*)(x + (size_t)m * DM) + F.lane;
        const GAS v2u* yr = (const GAS v2u*)(Y + (size_t)m * DM) + F.lane;
        f32x4 v[16]; float s = 0.f;
#pragma unroll
        for (int j = 0; j < 16; ++j) { const f32x4 xv = xr[64 * j]; const v2u yv = yr[64 * j];
            v[j].x = DEEPNORM_ALPHA * xv.x + bf2f(yv.x & 0xffffu); v[j].y = DEEPNORM_ALPHA * xv.y + bf2f(yv.x >> 16);
            v[j].z = DEEPNORM_ALPHA * xv.z + bf2f(yv.y & 0xffffu); v[j].w = DEEPNORM_ALPHA * xv.w + bf2f(yv.y >> 16);
            s += (v[j].x + v[j].y) + (v[j].z + v[j].w); }
        const float mean = wave_sum(s) * (1.0f / DM); float s2 = 0.f;
#pragma unroll
        for (int j = 0; j < 16; ++j) { v[j] = v[j] - mean; s2 += (v[j].x * v[j].x + v[j].y * v[j].y) + (v[j].z * v[j].z + v[j].w * v[j].w); }
        const float rstd = 1.0f / sqrtf(wave_sum(s2) * (1.0f / DM) + LN_EPS);
        GAS f32x4* orow = (GAS f32x4*)(out + (size_t)m * DM) + F.lane;
        const GAS f32x4* gr = (const GAS f32x4*)ln_g + F.lane; const GAS f32x4* br = (const GAS f32x4*)ln_b + F.lane;
        const float inj = (m == gw) ? inject : 0.f;
#pragma unroll
        for (int j = 0; j < 16; ++j) orow[64 * j] = v[j] * rstd * gr[64 * j] + br[64 * j] + inj;
    }
}

#ifndef MK_N_LAUNCHES
#define MK_N_LAUNCHES 1
#endif
constexpr int N_PHASES = 4;
struct Args { const float* in[14]; float* out; unsigned char* ws; int ph_lo, ph_hi; };
__global__ void __launch_bounds__(NWAVES * 64, 2) hymba_fwd(Args args) {
    extern __shared__ __attribute__((aligned(16))) unsigned char lds[];
    Frame F;
    F.lds = (LAS unsigned char*)lds;
    F.MISC = (volatile LAS unsigned*)(F.lds + MISC_OFF);
    F.tid = threadIdx.x; F.lane = F.tid & 63; F.wave = __builtin_amdgcn_readfirstlane(F.tid >> 6);
    F.G = gridDim.x; { const int bx = blockIdx.x; F.vcu = (F.G % 8 == 0) ? (bx % 8) * (F.G / 8) + bx / 8 : bx; }
    F.ws = args.ws; F.ctl = (gu32*)(args.ws + WS_CTL); F.kargs = (const CAS unsigned char*)__builtin_amdgcn_kernarg_segment_ptr();
    if (F.tid < 64) ((LAS unsigned*)(F.lds + MISC_OFF))[F.tid] = 0u;
    __syncthreads();
    const int lo = args.ph_lo, hi = args.ph_hi;
#ifdef PROBE_A
#define STAMP(k) do { __syncthreads(); if (F.tid == 0) F.MISC[20 + (k)] = (unsigned)__builtin_amdgcn_s_memrealtime(); __syncthreads(); } while (0)
#else
#define STAMP(k) do { } while (0)
#endif
    STAMP(0);
    XcdBarrier bar; bar.bar = (unsigned*)(F.ctl + CW_BAR); bar.x = 0; bar.st = nullptr;
    if (hi - lo > 1) bar = xcd_barrier_post((unsigned*)(F.ctl + CW_BAR), F.MISC + 8);
#ifdef ONLY_PHASE
#define IN(k) ((k) == ONLY_PHASE)
#else
#define IN(k) (lo <= (k) && (k) < hi)
#endif
#define BOTH(k) (IN(k) && IN((k) + 1))
    if (IN(0)) { p0_prologue(F); STAMP(10); if (BOTH(0)) xcd_barrier(bar); }
    STAMP(1);
    if (IN(1)) {
        gu32* early = F.ctl + CW_EARLY; gu32* qhead = F.ctl + CW_QHEAD;
        {   pg8::Gemm g{WSP(bf16, WS_ACAT), WSP(bf16, WS_BTCAT), MROWS + MEMROWS, NPROJ + 2048, DM}; pg8::InProjOrder S; S.G = F.G; S.c = (int)blockIdx.x; S.early = (unsigned*)early;
            pg8::EpiProj E{WSP(bf16, WS_PROJ), NPROJ, WSP(bf16, WS_MKV), 2048};
            pg8::gemm_phase<pg8::EpiProj, pg8::InProjOrder, false, true>(F.lds, g, S, E); }
        STAMP(2);
        constexpr int Q_W = 128, Q_CLOC = Q_W + 256, Q_SWA1 = Q_CLOC + 64, Q_SCAN = Q_SWA1 + 65, Q_SWA2 = Q_SCAN + 192, Q_MOUT = Q_SWA2 + 256, Q_CROSS = Q_MOUT + 256, Q_END = Q_CROSS;
        int acq = 0;
        for (;;) {
            if (F.tid == 0) F.MISC[16] = __hip_atomic_fetch_add(qhead, 1u, RLX_AGENT);
            __syncthreads();
            const int q = (int)F.MISC[16];
            __syncthreads();
            if (q >= Q_END) break;
            const int need = q < Q_W ? 0 : (q < Q_SWA1 ? 1 : (q < Q_SCAN ? 2 : (q < Q_SWA2 ? 1 : (q < Q_MOUT ? 3 : 1))));
            if (acq < need) {
                if (F.tid == 0) {
                    gu32* w = need == 1 ? early : (need == 2 ? F.ctl + CW_CLOCDONE : F.ctl + CW_SCANDONE);
                    const unsigned want = need == 1 ? (unsigned)F.G * NWAVES : (need == 2 ? 256u : 65u); unsigned sp = 0;
                    while (__hip_atomic_load(w, RLX_AGENT) < want) { __builtin_amdgcn_s_sleep(4); if (++sp > (1u << 23)) break; }
                    if (need == 3) while (__hip_atomic_load(F.ctl + CW_LATE, RLX_AGENT) < 144u * NWAVES) { __builtin_amdgcn_s_sleep(4); if (++sp > (1u << 23)) break; }
                    __builtin_amdgcn_fence(__ATOMIC_ACQUIRE, "agent"); asm volatile("s_waitcnt vmcnt(0)" ::: "memory"); }
                __syncthreads();
                acq = need;
                if (need == 1) STAMP(3);
            }
            if (q < Q_W) wout_item(F, q);
            else if (q < Q_CLOC) cloc_item3(F, q - Q_W);
            else if (q < Q_SWA1) swa_item4(F, q - Q_CLOC);
            else if (q < Q_SCAN) scan_item(F, q - Q_SWA1);
            else if (q < Q_SWA2) swa_item4(F, q - Q_SCAN + 64);
            else if (q < Q_MOUT) mout_item3(F, q - Q_SWA2);
            else cross_item3(F, q - Q_MOUT);
        }
        STAMP(4);
        if (BOTH(1)) xcd_barrier(bar);
    }
    STAMP(5); STAMP(6); STAMP(7);
    if (IN(2)) {
        pg8::Gemm g{WSP(bf16, WS_MIX), WSP(bf16, WS_WOT), MROWS, DM, DM}; pg8::StaticOrder S; S.init(MROWS, DM, F.G, (int)blockIdx.x);
        pg8::EpiY E{WSP(bf16, WS_Y), DM};
        pg8::gemm_phase<pg8::EpiY, pg8::StaticOrder, false, true>(F.lds, g, S, E);
        STAMP(13);
        if (BOTH(2)) xcd_barrier(bar);
    }
    STAMP(8);
    float inject = 0.f;
#ifdef PROBE_A
    STAMP(9);
    if ((int)blockIdx.x == PROBE_BLK) { const unsigned dt = F.MISC[20 + PROBE_B] - F.MISC[20 + PROBE_A]; inject = sqrtf(5.12e-3f * ((float)dt * 0.01f) / (float)(PROBE_FULL)); }
#endif
    if (IN(3)) ln_phase(F, inject);
#undef IN
#undef BOTH
}

extern "C" void kernel_launch(void* const* d_in, const int* in_sizes, int n_in, void* d_out, int out_size, void* d_ws, size_t ws_size, hipStream_t stream) {
    static int grid = 0;
    if (grid == 0) {
        if (n_in != 14 || in_sizes[0] != MROWS * DM || out_size != MROWS * DM || ws_size < WS_END) { fprintf(stderr, "kernel_launch: unexpected shapes (n_in %d, in0 %d, out %d, ws %zu); nothing launched\n", n_in, n_in > 0 ? in_sizes[0] : -1, out_size, ws_size); grid = -1; return; }
        int dev = 0, cus = 0, per_cu = 0;
        if (hipGetDevice(&dev) != hipSuccess || hipDeviceGetAttribute(&cus, hipDeviceAttributeMultiprocessorCount, dev) != hipSuccess) { grid = -1; return; }
        if (hipFuncSetAttribute((const void*)hymba_fwd, hipFuncAttributeMaxDynamicSharedMemorySize, LDS_BYTES) != hipSuccess) { fprintf(stderr, "kernel_launch: hipFuncSetAttribute failed\n"); grid = -1; return; }
        if (hipOccupancyMaxActiveBlocksPerMultiprocessor(&per_cu, (const void*)hymba_fwd, NWAVES * 64, LDS_BYTES) != hipSuccess || per_cu < 1) { fprintf(stderr, "kernel_launch: occupancy query says %d blocks per CU; nothing launched\n", per_cu); (void)hipGetLastError(); grid = -1; return; }
        grid = cus;
    }
    if (grid < 0) return;
    (void)hipMemsetAsync((char*)d_ws + WS_CTL, 0, CTL_ZERO_BYTES, stream);
    Args a{};
    for (int i = 0; i < 14; ++i) a.in[i] = (const float*)d_in[i];
    a.out = (float*)d_out; a.ws = (unsigned char*)d_ws;
#if MK_N_LAUNCHES == 1
    a.ph_lo = 0; a.ph_hi = N_PHASES;
    void* kargs[] = {&a};
    const hipError_t le = hipLaunchCooperativeKernel((const void*)hymba_fwd, dim3(grid), dim3(NWAVES * 64), kargs, LDS_BYTES, stream);
    if (le != hipSuccess) fprintf(stderr, "kernel_launch: cooperative launch failed: %s (grid %d)\n", hipGetErrorString(le), grid);
#ifdef PROBE_EXTRA
    a.ph_lo = PROBE_EXTRA; a.ph_hi = PROBE_EXTRA + 1; hipLaunchKernelGGL(hymba_fwd, dim3(grid), dim3(NWAVES * 64), LDS_BYTES, stream, a);
#endif
#else
    for (int p = 0; p < N_PHASES; ++p) { a.ph_lo = p; a.ph_hi = p + 1; hipLaunchKernelGGL(hymba_fwd, dim3(grid), dim3(NWAVES * 64), LDS_BYTES, stream, a); }
#endif
}
```

```cpp
#include <hip/hip_runtime.h>
#include <cstdio>
#include <cstdint>
#include <cstddef>
namespace pg8 {
#define PG8_LAS __attribute__((address_space(3)))
typedef unsigned short bf16_t;
typedef short bf16x8 __attribute__((ext_vector_type(8)));
typedef float f32x4 __attribute__((ext_vector_type(4)));
typedef unsigned u32x4 __attribute__((ext_vector_type(4)));
constexpr int BM = 256, BK = 64, HALF = 128, HTB = HALF * BK * 2  , STAGE_BYTES = 8 * HTB, NXCD = 8, WGM = 8;

__host__ __device__ __forceinline__ int lds_byte(int r, int c) { const int st = (r >> 4) * 2 + (c >> 5), rr = r & 15, cc = c & 31, ob = rr * 64 + cc * 2; return st * 1024 + (ob ^ (((ob >> 9) & 1) << 5)); }
__host__ __device__ __forceinline__ void stage_rc(int b, int& R, int& C) { const int st = b / 1024, sb = b % 1024, swz = sb ^ (((sb >> 9) & 1) << 5); R = (st >> 1) * 16 + swz / 64; C = (st & 1) * 32 + (swz % 64) / 2; }
__host__ __device__ __forceinline__ int perm32(int rho) { const int n = rho >> 4, i = rho & 15; return 8 * (i >> 2) + 4 * n + (i & 3); }

struct Unit { int pm, pn, tag; };
struct Gemm { const bf16_t* A; const bf16_t* Bt; int M, N, K; };

struct StaticOrder {
    int nM, nN, nwg, G, c;
    __host__ __device__ void init(int M, int N, int G_, int c_) { nM = M / BM; nN = N / BM; nwg = nM * nN; G = G_; c = c_; }
    __host__ __device__ bool next(int i, Unit& u) const {
        const long L = (long)i * G + c; if (L >= nwg) return false;
        int wgid = (int)L; { const int q = nwg / NXCD, r = nwg % NXCD, xcd = wgid % NXCD, off = wgid / NXCD; wgid = (xcd < r ? xcd * (q + 1) : r * (q + 1) + (xcd - r) * q) + off; }
        const int nig = WGM * nN, gid = wgid / nig, fm = gid * WGM, gsz = (nM - fm) < WGM ? (nM - fm) : WGM;
        u.pm = fm + ((wgid % nig) % gsz); u.pn = (wgid % nig) / gsz; u.tag = 0; return true;
    }
    __device__ __forceinline__ void a_ready(const Unit&) const {}
    __device__ __forceinline__ void done(const Unit&) const {}
};
__device__ __forceinline__ unsigned cvt_pk_bf16(float lo, float hi) { unsigned r; asm volatile("v_cvt_pk_bf16_f32 %0, %1, %2" : "=v"(r) : "v"(lo), "v"(hi)); return r; }
typedef float f32x2 __attribute__((ext_vector_type(2)));
__device__ __forceinline__ float sigmoid_f(float v) { return __builtin_amdgcn_rcpf(1.0f + __builtin_amdgcn_exp2f(-1.4426950408889634f * v)); }
struct EpiProj {
    static constexpr bool PERM = true, AFTER_DRAIN = false;
    bf16_t* P; int ldp; bf16_t* MKV; int ldm;
    __device__ __forceinline__ void operator()(const f32x4 (&acc)[2][2][4][2], const Unit& u, int wr, int wc, int fr, int fq) const {
        bf16_t* tbase; unsigned tbytes; unsigned boff; int ld; int act = 0;
        if (u.pm < 32) { tbase = P; tbytes = 8192u * 11264u * 2u; boff = (unsigned)(u.pm * BM) * (unsigned)ldp + (unsigned)(u.pn * BM); ld = ldp; const int pn = u.pn;
            act = ((pn >= 12 && pn < 20) || (pn >= 32 && pn < 36) || pn >= 40) ? 1 : ((pn >= 28 && pn < 32) ? 2 : 0); }
        else { tbase = MKV; tbytes = 512u * 2048u * 2u; boff = (unsigned)((u.pm - 32) * BM) * (unsigned)ldm + (unsigned)((u.pn - 44) * BM); ld = ldm; }
        const __amdgpu_buffer_rsrc_t rsrc = __builtin_amdgcn_make_buffer_rsrc(tbase, 0, tbytes, 0x00020000);
        const int row0 = wr * 64 + fr, col0 = wc * 32 + 8 * fq;
#pragma unroll
        for (int ai = 0; ai < 2; ++ai)
#pragma unroll
            for (int m = 0; m < 4; ++m) { const unsigned rowoff = (boff + (unsigned)(row0 + ai * HALF + m * 16) * (unsigned)ld + (unsigned)col0) * 2u;
#pragma unroll
                for (int bj = 0; bj < 2; ++bj) { f32x4 v0 = acc[ai][bj][m][0], v1 = acc[ai][bj][m][1];
                    if (act == 1) {
#pragma unroll
                        for (int j = 0; j < 4; ++j) { v0[j] = v0[j] * sigmoid_f(v0[j]); v1[j] = v1[j] * sigmoid_f(v1[j]); } }
                    else if (act == 2) {
#pragma unroll
                        for (int j = 0; j < 4; ++j) { v0[j] = sigmoid_f(v0[j]); v1[j] = sigmoid_f(v1[j]); } }
                    u32x4 w; w.x = cvt_pk_bf16(v0[0], v0[1]); w.y = cvt_pk_bf16(v0[2], v0[3]); w.z = cvt_pk_bf16(v1[0], v1[1]); w.w = cvt_pk_bf16(v1[2], v1[3]);
                    __builtin_amdgcn_raw_buffer_store_b128(w, rsrc, rowoff + (unsigned)(bj * HALF * 2), 0, 16  ); } }
    }
};
struct EpiY {
    static constexpr bool PERM = true, AFTER_DRAIN = false;
    bf16_t* O; int ldc;
    __device__ __forceinline__ void operator()(const f32x4 (&acc)[2][2][4][2], const Unit& u, int wr, int wc, int fr, int fq) const {
        bf16_t* base = O + (size_t)(u.pm * BM) * ldc + u.pn * BM;
        const int row0 = wr * 64 + fr, col0 = wc * 32 + 8 * fq;
#pragma unroll
        for (int ai = 0; ai < 2; ++ai)
#pragma unroll
            for (int m = 0; m < 4; ++m) { bf16_t* rowp = base + (size_t)(row0 + ai * HALF + m * 16) * ldc + col0;
#pragma unroll
                for (int bj = 0; bj < 2; ++bj) { const f32x4 v0 = acc[ai][bj][m][0], v1 = acc[ai][bj][m][1];
                    u32x4 w; w.x = cvt_pk_bf16(v0[0], v0[1]); w.y = cvt_pk_bf16(v0[2], v0[3]); w.z = cvt_pk_bf16(v1[0], v1[1]); w.w = cvt_pk_bf16(v1[2], v1[3]);
                    *(u32x4*)(rowp + bj * HALF) = w; } }
    }
};
struct InProjOrder {
    int G, c; unsigned* early;
    __device__ __forceinline__ bool next(int i, Unit& u) const {
        const int L = i * G + c; if (L >= 1424) return false;
        u.tag = (L >= 1280) ? 2 : ((L + G >= 1280) ? 1 : 0);
        if (L < 16) { u.pm = 32 + (L >> 3); u.pn = 44 + (L & 7); return true; }
        const int Lp = L - 16, xcd = Lp % NXCD, off = Lp / NXCD;
        const int ci = off >> 3, row = off & 7;
        u.pm = 8 * (xcd >> 1) + row;
        u.pn = (xcd & 1) ? (ci == 0 ? 19 : (ci < 9 ? 19 + ci : (ci < 17 ? 27 + ci : (ci < 20 ? 16 + ci : 10 + ci)))) : (ci < 19 ? ci : (ci == 19 ? 32 : 8 + ci));
        return true;
    }
    __device__ __forceinline__ void a_ready(const Unit&) const {}
    __device__ __forceinline__ void done(const Unit& u) const {
        if (u.tag) {
            asm volatile("s_waitcnt vmcnt(0)" ::: "memory");
            if ((threadIdx.x & 63) == 0) __hip_atomic_fetch_add(u.tag == 1 ? early : early + 64, 1u, __ATOMIC_RELAXED, __HIP_MEMORY_SCOPE_AGENT);
        }
    }
};
template <class Epi, class Sched, bool ALIGN_EPI = false, bool SP2 = false>
__device__ __forceinline__ void gemm_phase(PG8_LAS unsigned char* lds, const Gemm g, const Sched& S, const Epi& E) {
    const int tid = threadIdx.x, wid = __builtin_amdgcn_readfirstlane(tid >> 6), lane = tid & 63, wr = wid >> 2, wc = wid & 3, fr = lane & 15, fq = lane >> 4;
    const int K = g.K, nt = K / BK;
    unsigned voffA[2], voffB[2];
#pragma unroll
    for (int i = 0; i < 2; ++i) { int R, C; stage_rc(tid * 16 + i * 8192, R, C); const int Rb = Epi::PERM ? ((R & ~31) + perm32(R & 31)) : R;
        voffA[i] = (unsigned)(R * K + C) * 2u; voffB[i] = (unsigned)(Rb * K + C) * 2u; }
    const size_t kstep = (size_t)(BK * 2);
    const size_t hstep = (size_t)HALF * K * 2;
    const size_t tstep = 2 * hstep;
    const unsigned ldsw = (unsigned)wid * 1024u;
    const int aoff = lds_byte(wr * 64 + fr, fq * 8), boff = lds_byte(wc * 32 + fr, fq * 8);
#define PG8_SA(b, h) (((b) * 2 + (h)) * HTB)
#define PG8_SB(b, h) ((4 + (b) * 2 + (h)) * HTB)
#define PG8_STAGE(bufoff, gbase, voff) do { _Pragma("unroll") for (int _i = 0; _i < 2; ++_i) \
        __builtin_amdgcn_global_load_lds((const unsigned*)((const char*)(gbase) + (voff)[_i]), (PG8_LAS unsigned*)(lds + (bufoff) + ldsw + _i * 8192), 16, 0, 0); } while (0)
#define PG8_LDA(dst, b, h) do { _Pragma("unroll") for (int m = 0; m < 4; ++m) _Pragma("unroll") for (int k = 0; k < 2; ++k) dst[m][k] = *(const PG8_LAS bf16x8*)(lds + PG8_SA(b, h) + aoff + m * 2048 + k * 1024); } while (0)
#define PG8_LDB(dst, b, h) do { _Pragma("unroll") for (int n = 0; n < 2; ++n) _Pragma("unroll") for (int k = 0; k < 2; ++k) dst[n][k] = *(const PG8_LAS bf16x8*)(lds + PG8_SB(b, h) + boff + n * 2048 + k * 1024); } while (0)
#define PG8_MMA(ai, bj, At, Bt) do { __builtin_amdgcn_s_setprio(1); _Pragma("unroll") for (int m = 0; m < 4; ++m) _Pragma("unroll") for (int n = 0; n < 2; ++n) _Pragma("unroll") for (int k = 0; k < 2; ++k) \
        acc[ai][bj][m][n] = __builtin_amdgcn_mfma_f32_16x16x32_bf16(Bt[n][k], At[m][k], acc[ai][bj][m][n], 0, 0, 0); __builtin_amdgcn_s_setprio(0); } while (0)
#define PG8_WAIT_V(n) asm volatile("s_waitcnt vmcnt(" #n ")" ::: "memory")
#define PG8_WAIT_L(n) asm volatile("s_waitcnt lgkmcnt(" #n ")" ::: "memory")
#define PG8_BAR __builtin_amdgcn_s_barrier()
#define PG8_SCHED __builtin_amdgcn_sched_barrier(0)
    Unit cur, nxt; int ui = 0;
    if (!S.next(0, cur)) return;
    f32x4 acc[2][2][4][2];
#pragma unroll
    for (int a = 0; a < 2; ++a)
#pragma unroll
        for (int b = 0; b < 2; ++b)
#pragma unroll
            for (int m = 0; m < 4; ++m)
#pragma unroll
                for (int n = 0; n < 2; ++n) acc[a][b][m][n] = (f32x4){0.f, 0.f, 0.f, 0.f};
    bf16x8 At[4][2], B0[2][2], B1[2][2];
    const char* cA = (const char*)g.A + (size_t)cur.pm * tstep; const char* cB = (const char*)g.Bt + (size_t)cur.pn * tstep;
    S.a_ready(cur);
    if constexpr (SP2) {
        PG8_STAGE(PG8_SB(0, 0), cB, voffB); PG8_STAGE(PG8_SB(0, 1), cB + hstep, voffB); PG8_STAGE(PG8_SA(0, 0), cA, voffA); PG8_STAGE(PG8_SA(0, 1), cA + hstep, voffA);
        if (wr == 1) PG8_BAR;
        PG8_WAIT_V(2); PG8_BAR;
        PG8_STAGE(PG8_SB(1, 0), cB + kstep, voffB); PG8_STAGE(PG8_SA(1, 0), cA + kstep, voffA); PG8_STAGE(PG8_SB(1, 1), cB + hstep + kstep, voffB);
        PG8_WAIT_V(6); PG8_BAR;
    } else {
        PG8_STAGE(PG8_SB(0, 0), cB, voffB); PG8_STAGE(PG8_SA(0, 0), cA, voffA); PG8_STAGE(PG8_SB(0, 1), cB + hstep, voffB); PG8_STAGE(PG8_SA(0, 1), cA + hstep, voffA);
        if (wr == 1) PG8_BAR;
        PG8_WAIT_V(4); PG8_BAR;
        PG8_STAGE(PG8_SB(1, 0), cB + kstep, voffB); PG8_STAGE(PG8_SA(1, 0), cA + kstep, voffA); PG8_STAGE(PG8_SB(1, 1), cB + hstep + kstep, voffB);
        PG8_WAIT_V(6); PG8_BAR;
    }
    for (;;) {
        const bool has_next = S.next(ui + 1, nxt);
        const char* nA = has_next ? (const char*)g.A + (size_t)nxt.pm * tstep : cA; const char* nB = has_next ? (const char*)g.Bt + (size_t)nxt.pn * tstep : cB;
        for (int t = 0; t < nt; t += 2) {
            const bool last = (t == nt - 2);
            const char* a1 = cA + (size_t)(t + 1) * kstep;
            const char* a2 = last ? nA : cA + (size_t)(t + 2) * kstep; const char* b2 = last ? nB : cB + (size_t)(t + 2) * kstep;
            const char* a3 = a2 + kstep; const char* b3 = b2 + kstep;
            if (last && has_next) S.a_ready(nxt);
            if constexpr (SP2) {
            PG8_LDB(B0, 0, 0); PG8_LDB(B1, 0, 1); PG8_SCHED; PG8_LDA(At, 0, 0); PG8_STAGE(PG8_SA(1, 1), a1 + hstep, voffA);
            PG8_WAIT_V(8); PG8_WAIT_L(0); PG8_BAR; PG8_MMA(0, 0, At, B0); PG8_MMA(0, 1, At, B1); PG8_BAR; PG8_SCHED;
            PG8_LDA(At, 0, 1); PG8_STAGE(PG8_SB(0, 0), b2, voffB); PG8_STAGE(PG8_SB(0, 1), b2 + hstep, voffB); PG8_STAGE(PG8_SA(0, 0), a2, voffA);
            PG8_WAIT_V(8); PG8_WAIT_L(0); PG8_BAR; PG8_MMA(1, 0, At, B0); PG8_MMA(1, 1, At, B1); PG8_BAR; PG8_SCHED;
            PG8_LDB(B0, 1, 0); PG8_LDB(B1, 1, 1); PG8_SCHED; PG8_LDA(At, 1, 0); PG8_STAGE(PG8_SA(0, 1), a2 + hstep, voffA);
            PG8_WAIT_V(8); PG8_WAIT_L(0); PG8_BAR; PG8_MMA(0, 0, At, B0); PG8_MMA(0, 1, At, B1); PG8_BAR; PG8_SCHED;
            PG8_LDA(At, 1, 1); PG8_STAGE(PG8_SB(1, 0), b3, voffB); PG8_STAGE(PG8_SB(1, 1), b3 + hstep, voffB); PG8_STAGE(PG8_SA(1, 0), a3, voffA);
            PG8_WAIT_V(8); PG8_WAIT_L(0); PG8_BAR; PG8_MMA(1, 0, At, B0); PG8_MMA(1, 1, At, B1); PG8_BAR; PG8_SCHED;
            } else {
            PG8_LDB(B0, 0, 0); PG8_SCHED; PG8_LDA(At, 0, 0); PG8_STAGE(PG8_SA(1, 1), a1 + hstep, voffA);
            PG8_WAIT_L(8); PG8_BAR; PG8_WAIT_L(0); PG8_MMA(0, 0, At, B0); PG8_BAR; PG8_SCHED;
            PG8_LDB(B1, 0, 1); PG8_STAGE(PG8_SB(0, 0), b2, voffB);
            PG8_BAR; PG8_WAIT_L(0); PG8_MMA(0, 1, At, B1); PG8_BAR;
            PG8_LDA(At, 0, 1); PG8_STAGE(PG8_SA(0, 0), a2, voffA);
            PG8_BAR; PG8_WAIT_L(0); PG8_MMA(1, 0, At, B0); PG8_BAR; PG8_SCHED;
            PG8_STAGE(PG8_SB(0, 1), b2 + hstep, voffB);
            PG8_WAIT_V(6); PG8_BAR; PG8_MMA(1, 1, At, B1); PG8_BAR;
            PG8_LDB(B0, 1, 0); PG8_SCHED; PG8_LDA(At, 1, 0); PG8_STAGE(PG8_SA(0, 1), a2 + hstep, voffA);
            PG8_WAIT_L(8); PG8_BAR; PG8_WAIT_L(0); PG8_MMA(0, 0, At, B0); PG8_BAR; PG8_SCHED;
            PG8_LDB(B1, 1, 1); PG8_STAGE(PG8_SB(1, 0), b3, voffB);
            PG8_BAR; PG8_WAIT_L(0); PG8_MMA(0, 1, At, B1); PG8_BAR;
            PG8_LDA(At, 1, 1); PG8_STAGE(PG8_SA(1, 0), a3, voffA);
            PG8_BAR; PG8_WAIT_L(0); PG8_MMA(1, 0, At, B0); PG8_BAR; PG8_SCHED;
            PG8_STAGE(PG8_SB(1, 1), b3 + hstep, voffB);
            PG8_WAIT_V(6); PG8_BAR; PG8_MMA(1, 1, At, B1); PG8_BAR;
            }
        }
        if constexpr (ALIGN_EPI) { if (wr == 0) PG8_BAR; }
        if constexpr (!Epi::AFTER_DRAIN) { E(acc, cur, wr, wc, fr, fq); S.done(cur); }
        if (!has_next) break;
#pragma unroll
        for (int a = 0; a < 2; ++a)
#pragma unroll
            for (int b = 0; b < 2; ++b)
#pragma unroll
                for (int m = 0; m < 4; ++m)
#pragma unroll
                    for (int n = 0; n < 2; ++n) acc[a][b][m][n] = (f32x4){0.f, 0.f, 0.f, 0.f};
        cur = nxt; cA = nA; cB = nB; ++ui;
        if constexpr (ALIGN_EPI) { if (wr == 1) PG8_BAR; }
    }
    PG8_WAIT_V(0);
    if constexpr (!ALIGN_EPI) { if (wr == 0) PG8_BAR; }
    PG8_BAR;
    if constexpr (Epi::AFTER_DRAIN) { E.fused(acc, cur, wr, wc, fr, fq, lds, wid, lane); S.done(cur); }
#undef PG8_SA
#undef PG8_SB
#undef PG8_STAGE
#undef PG8_LDA
#undef PG8_LDB
#undef PG8_MMA
#undef PG8_WAIT_V
#undef PG8_WAIT_L
#undef PG8_BAR
#undef PG8_SCHED
}
}
#define GAS __attribute__((address_space(1)))
#define LAS __attribute__((address_space(3)))
typedef unsigned short bf16;
typedef unsigned v4u __attribute__((ext_vector_type(4)));
typedef float f32x4 __attribute__((ext_vector_type(4)));
typedef short bf16x8 __attribute__((ext_vector_type(8)));
typedef GAS unsigned gu32;
typedef GAS unsigned long long gu64;
#define RLX_AGENT __ATOMIC_RELAXED, __HIP_MEMORY_SCOPE_AGENT
#define LDS_WAIT() asm volatile("s_waitcnt lgkmcnt(0)" ::: "memory")
#define VM_WAIT() asm volatile("s_waitcnt vmcnt(0)" ::: "memory")
__device__ __forceinline__ unsigned long long rt() { return __builtin_amdgcn_s_memrealtime(); }
__device__ __forceinline__ unsigned f2bf(float f) { unsigned u = __builtin_bit_cast(unsigned, f); return (u + 0x7fffu + ((u >> 16) & 1u)) >> 16; }
__device__ __forceinline__ unsigned pk2(float lo, float hi) { return f2bf(lo) | (f2bf(hi) << 16); }

#define XB_TMO      128
#define XB_XCNT(j)  (256  + 64 * (j))
#define XB_XSUB(j)  (1280 + 64 * (j))
#define XB_XGEN(j)  (2304 + 64 * (j))
#define XB_TOP      3328
#define XB_TOPGEN   3392
#define XCD_BAR_WORDS 3456
#define XB_SPIN_CAP (1u << 18)

__device__ __forceinline__ unsigned xb_ld(unsigned* p)              { return __hip_atomic_load(p, __ATOMIC_RELAXED, __HIP_MEMORY_SCOPE_AGENT); }
__device__ __forceinline__ unsigned xb_add(unsigned* p, unsigned v) { return __hip_atomic_fetch_add(p, v, __ATOMIC_RELAXED, __HIP_MEMORY_SCOPE_AGENT); }
__device__ __forceinline__ unsigned xb_xcc_id() { return (unsigned)__builtin_amdgcn_s_getreg((3 << 11) | 20) & 0xFu; }
#define XB_SPIN(cond, bar) do { unsigned _sp = 0; while (cond) { __builtin_amdgcn_s_sleep(1); \
    if ((++_sp & 255u) == 0u) { if (xb_ld(&(bar)[XB_TMO])) break; if (_sp > XB_SPIN_CAP) { atomicAdd(&(bar)[XB_TMO], 1u); break; } } } } while (0)

struct XcdBarrier {
    unsigned* bar; unsigned x;
    volatile LAS unsigned* st;
};

__device__ __forceinline__ XcdBarrier xcd_barrier_post(unsigned* bar, volatile LAS unsigned* st) {
    XcdBarrier b; b.bar = bar; b.x = xb_xcc_id(); b.st = st;
    if (threadIdx.x == 0) (void)xb_add(&bar[XB_XCNT(b.x)], 1u);
    return b;
}
__device__ __forceinline__ void xcd_barrier_complete(unsigned* bar, unsigned x, unsigned& nloc, unsigned& nx) {
    const unsigned G = gridDim.x * gridDim.y * gridDim.z;
    unsigned sum, cnt, mine, sp = 0u;
    for (;;) {
        sum = 0u; cnt = 0u; mine = 0u;
#pragma unroll
        for (unsigned j = 0; j < 16; ++j) { const unsigned c = xb_ld(&bar[XB_XCNT(j)]); sum += c; cnt += (c > 0u) ? 1u : 0u; mine = (j == x) ? c : mine; }
        if (sum == G) break;
        __builtin_amdgcn_s_sleep(1);
        if ((++sp & 255u) == 0u) { if (xb_ld(&bar[XB_TMO])) break; if (sp > XB_SPIN_CAP) { atomicAdd(&bar[XB_TMO], 1u); break; } }
    }
    nloc = mine > 0u ? mine : 1u; nx = cnt > 0u ? cnt : 1u;
}

__device__ __forceinline__ void xcd_barrier(const XcdBarrier& b) {
    asm volatile("s_waitcnt vmcnt(0)" ::: "memory");
    __syncthreads();
    if (threadIdx.x == 0) {
        unsigned* bar = b.bar;
        __builtin_amdgcn_s_waitcnt(0);
        unsigned nloc = b.st[0], nx = b.st[1];
        if (nloc == 0u) { xcd_barrier_complete(bar, b.x, nloc, nx); b.st[0] = nloc; b.st[1] = nx; }
        const unsigned old = xb_add(&bar[XB_XSUB(b.x)], 1u);
        const unsigned gen = old / nloc;
        if (old + 1u == (gen + 1u) * nloc) {
            __builtin_amdgcn_fence(__ATOMIC_RELEASE, "agent");
            asm volatile("s_waitcnt vmcnt(0)" ::: "memory");
            const unsigned og = xb_add(&bar[XB_TOP], 1u);
            const unsigned tg = og / nx;
            if (og + 1u == (tg + 1u) * nx) xb_add(&bar[XB_TOPGEN], 1u);
            else XB_SPIN(xb_ld(&bar[XB_TOPGEN]) == tg, bar);
            __builtin_amdgcn_fence(__ATOMIC_ACQUIRE, "agent");
            xb_add(&bar[XB_XGEN(b.x)], 1u);
            asm volatile("s_waitcnt vmcnt(0)" ::: "memory");
        } else {
            XB_SPIN(xb_ld(&bar[XB_XGEN(b.x)]) == gen, bar);
            __builtin_amdgcn_fence(__ATOMIC_ACQUIRE, "agent");
            asm volatile("s_waitcnt vmcnt(0)" ::: "memory");
        }
    }
    __syncthreads();
}
constexpr int NWAVES = 8;
constexpr int DM = 4096, SEQ = 4096, MROWS = 8192, MEMROWS = 512;
constexpr int INW = 11272;
constexpr int NPROJ = 11264;
constexpr int C_AQ = 0, C_AK = 2048, C_AV = 2560, C_AZ = 3072, C_MQ = 5120, C_MK = 5632, C_MV = 6144, C_MO = 7168, C_MZ = 8192, C_CQ = 9216, C_CZ = 10240;
constexpr float LN_EPS = 1e-5f, HEAD_NORM_EPS = 1e-6f;
constexpr float DEEPNORM_ALPHA = 1.189207115002721f;

constexpr size_t MiB = 1u << 20;
constexpr size_t WS_CTL = 0, CTL_ZERO_BYTES = 32768;
constexpr size_t WS_ACAT = 2 * MiB;
constexpr size_t WS_BTCAT = 70 * MiB;
constexpr size_t WS_WOT = 174 * MiB;
constexpr size_t WS_PROJ = 206 * MiB;
constexpr size_t WS_MKV = 382 * MiB;
constexpr size_t WS_GATES = 384 * MiB;
constexpr size_t WS_MQK = 385 * MiB;
constexpr size_t WS_CLOC = 401 * MiB;
constexpr size_t WS_CPREV = 435 * MiB;
constexpr size_t WS_SMALL = 452 * MiB;
constexpr size_t WS_MIX = 453 * MiB;
constexpr size_t WS_Y = 517 * MiB;
constexpr size_t WS_END = 581 * MiB;
constexpr int CW_BAR = 4096;
constexpr int CW_EARLY = 64, CW_LATE = 128  , CW_QHEAD = 192, CW_CLOCDONE = 256, CW_SCANDONE = 320;

constexpr int LDS_BYTES = 163840;
constexpr int MISC_OFF = LDS_BYTES - 256;

typedef unsigned v2u __attribute__((ext_vector_type(2)));
#define CAS __attribute__((address_space(4)))
struct Frame {
    LAS unsigned char* lds;
    volatile LAS unsigned* MISC;
    gu32* ctl;
    unsigned char* ws;
    const CAS unsigned char* kargs;
    int tid, lane, wave, G, vcu;
};
__device__ __forceinline__ const float* in_ptr(const Frame& F, int i) { const CAS unsigned char* p = F.kargs; asm volatile("" : "+s"(p)); return *(const float* const CAS*)(p + 8 * i); }
__device__ __forceinline__ float* out_ptr(const Frame& F) { const CAS unsigned char* p = F.kargs; asm volatile("" : "+s"(p)); return *(float* const CAS*)(p + 8 * 14); }
#define WSP(T, off) ((T*)(F.ws + (off)))
#ifdef PROBE_A
#define ISTAMP(k) do { __syncthreads(); if (F.tid == 0) F.MISC[20 + (k)] = (unsigned)__builtin_amdgcn_s_memrealtime(); __syncthreads(); } while (0)
#else
#define ISTAMP(k) do { } while (0)
#endif
__device__ __forceinline__ float bf2f(unsigned h) { return __builtin_bit_cast(float, h << 16); }
__device__ __forceinline__ float wave_sum(float v) {
#pragma unroll
    for (int o = 1; o < 64; o <<= 1) v += __shfl_xor(v, o);
    return v;
}
__device__ __forceinline__ float quad_max(float v) { v = fmaxf(v, __shfl_xor(v, 16)); v = fmaxf(v, __shfl_xor(v, 32)); return v; }
__device__ __forceinline__ float quad_sum(float v) { v += __shfl_xor(v, 16); v += __shfl_xor(v, 32); return v; }
__device__ __forceinline__ float row16_sum(float v) { v += __shfl_xor(v, 1); v += __shfl_xor(v, 2); v += __shfl_xor(v, 4); v += __shfl_xor(v, 8); return v; }
__device__ __forceinline__ float fast_exp(float v) { return __builtin_amdgcn_exp2f(1.4426950408889634f * v); }
__device__ __forceinline__ float sigmoidf_(float v) { return __builtin_amdgcn_rcpf(1.0f + fast_exp(-v)); }
__device__ __forceinline__ bf16x8 mk_frag(unsigned a, unsigned b, unsigned c, unsigned d) { v4u t; t.x = a; t.y = b; t.z = c; t.w = d; return __builtin_bit_cast(bf16x8, t); }
__device__ __forceinline__ bf16x8 ld_frag16(const LAS unsigned char* p) { return *(const LAS bf16x8*)p; }
__device__ __forceinline__ bf16x8 ld_frag8x2(const LAS unsigned char* p0, const LAS unsigned char* p1) {
    const v2u a = *(const LAS v2u*)p0, b = *(const LAS v2u*)p1; return mk_frag(a.x, a.y, b.x, b.y); }
#define MFMA16(a, b, c) __builtin_amdgcn_mfma_f32_16x16x32_bf16((a), (b), (c), 0, 0, 0)

__device__ __forceinline__ void stage_transposed(const bf16* src, size_t spitch, int nrows, int nch, LAS unsigned short* dst, int dpitch, const LAS float* rowscale, int tid) {
    for (int idx = tid; idx < nrows * nch; idx += NWAVES * 64) {
        const int row = idx & (nrows - 1), ch = idx / nrows;
        const v4u q = *(const GAS v4u*)(src + (size_t)row * spitch + ch * 8);
        unsigned e[8] = {q.x & 0xffffu, q.x >> 16, q.y & 0xffffu, q.y >> 16, q.z & 0xffffu, q.z >> 16, q.w & 0xffffu, q.w >> 16};
        LAS unsigned short* d = dst + (ch * 8) * dpitch + row;
        if (rowscale) { const float s = rowscale[row];
#pragma unroll
            for (int j = 0; j < 8; ++j) d[j * dpitch] = (unsigned short)f2bf(bf2f(e[j]) * s); }
        else {
#pragma unroll
            for (int j = 0; j < 8; ++j) d[j * dpitch] = (unsigned short)e[j]; }
    }
}

__device__ __forceinline__ void p0_transpose_item(const float* W, int ldw, bf16* WT, int row_off, LAS float* scr, int kb, int nb, int lane) {
    const int k0 = 64 * kb, n0 = 32 * nb;
    {   const int r8 = lane >> 3, cq = lane & 7;
        f32x4 t[8];
#pragma unroll
        for (int i = 0; i < 8; ++i) t[i] = *(const GAS f32x4*)(W + (size_t)(k0 + 8 * i + r8) * ldw + n0 + 4 * cq);
#pragma unroll
        for (int i = 0; i < 8; ++i) { LAS float* d = scr + (8 * i + r8) * 33 + 4 * cq; d[0] = t[i].x; d[1] = t[i].y; d[2] = t[i].z; d[3] = t[i].w; } }
    LDS_WAIT(); asm volatile("" ::: "memory");
    const int c = lane & 7;
#pragma unroll
    for (int j = 0; j < 4; ++j) { const int n = (lane >> 3) + 8 * j; const LAS float* s = scr + (8 * c) * 33 + n;
        v4u o; o.x = pk2(s[0 * 33], s[1 * 33]); o.y = pk2(s[2 * 33], s[3 * 33]); o.z = pk2(s[4 * 33], s[5 * 33]); o.w = pk2(s[6 * 33], s[7 * 33]);
        *(GAS v4u*)(WT + (size_t)(row_off + n0 + n) * DM + k0 + 8 * c) = o; }
    LDS_WAIT(); asm volatile("" ::: "memory");
}
__device__ __forceinline__ void wout_item(Frame& F, int item) {
    const float* w_out = in_ptr(F, 11); bf16* WOT = WSP(bf16, WS_WOT);
    LAS float* scr = (LAS float*)(F.lds + F.wave * 16384);
    for (int j = 0; j < 8; ++j) { const int r = item * 64 + j * 8 + F.wave; p0_transpose_item(w_out, DM, WOT, 0, scr, r / 128, r % 128, F.lane); }
    __syncthreads();
}
typedef __bf16 bf16x2_t __attribute__((ext_vector_type(2)));
__device__ __forceinline__ float dot2_bf16(unsigned w, unsigned x, float acc) { return __builtin_amdgcn_fdot2_f32_bf16(__builtin_bit_cast(bf16x2_t, w), __builtin_bit_cast(bf16x2_t, x), acc, false); }
__device__ __forceinline__ void p0_prologue(Frame& F) {
    const float* x = in_ptr(F, 0); const float* mem = in_ptr(F, 1); const float* w_in = in_ptr(F, 2); const float* b_i = in_ptr(F, 5); const float* b_f = in_ptr(F, 6); const float* w_mem_kv = in_ptr(F, 10); bf16* ACAT = WSP(bf16, WS_ACAT); bf16* BTCAT = WSP(bf16, WS_BTCAT); float* GATES = WSP(float, WS_GATES);
    const int gw = F.vcu * NWAVES + F.wave, NGW = F.G * NWAVES;
    LAS float* scr = (LAS float*)(F.lds + F.wave * 8448);
    LAS unsigned short* GW = (LAS unsigned short*)(F.lds + 67584);
    {   f32x4 ga[8], gb[8];
#pragma unroll
        for (int i = 0; i < 8; ++i) { const GAS f32x4* p = (const GAS f32x4*)(w_in + (size_t)(F.tid + 512 * i) * INW + 7168); ga[i] = p[0]; gb[i] = p[1]; }
#pragma unroll
        for (int i = 0; i < 8; ++i) { const int k = F.tid + 512 * i;
            GW[0 * DM + k] = (unsigned short)f2bf(ga[i].x); GW[1 * DM + k] = (unsigned short)f2bf(ga[i].y); GW[2 * DM + k] = (unsigned short)f2bf(ga[i].z); GW[3 * DM + k] = (unsigned short)f2bf(ga[i].w);
            GW[4 * DM + k] = (unsigned short)f2bf(gb[i].x); GW[5 * DM + k] = (unsigned short)f2bf(gb[i].y); GW[6 * DM + k] = (unsigned short)f2bf(gb[i].z); GW[7 * DM + k] = (unsigned short)f2bf(gb[i].w); } }
    __syncthreads();
    const float gate_bias = (F.lane < 4) ? b_i[F.lane] : ((F.lane < 8) ? b_f[F.lane - 4] : 0.f);
    constexpr int I0 = 64 * 224, I1 = 64 * 128, I2 = 64 * 64, NITEMS = I0 + I1 + I2;
    int it = gw;
#define P0_ITEMS(n) do { _Pragma("unroll 1") for (int c_ = 0; c_ < (n) && it < NITEMS; ++c_, it += NGW) { int r = it; \
        if (r < I0) p0_transpose_item(w_in, INW, BTCAT, 0, scr, r / 224, r % 224, F.lane); \
        else if ((r -= I0) < I1) p0_transpose_item(w_in + 7176, INW, BTCAT, 7168, scr, r / 128, r % 128, F.lane); \
        else { r -= I1; p0_transpose_item(w_mem_kv, 2048, BTCAT, 11264, scr, r / 64, r % 64, F.lane); } } } while (0)
#pragma unroll 1
    for (int m = gw; m < MROWS + MEMROWS; m += NGW) {
        const bool isx = m < MROWS;
        const GAS f32x4* xr = (const GAS f32x4*)((isx ? x : mem) + (size_t)(isx ? m : m - MROWS) * DM) + F.lane;
        f32x4 v[16];
#pragma unroll
        for (int j = 0; j < 16; ++j) v[j] = xr[64 * j];
        P0_ITEMS(3);
        GAS v2u* o8 = (GAS v2u*)(ACAT + (size_t)m * DM) + F.lane;
        v2u xp[16];
#pragma unroll
        for (int j = 0; j < 16; ++j) { xp[j].x = pk2(v[j].x, v[j].y); xp[j].y = pk2(v[j].z, v[j].w); o8[64 * j] = xp[j]; }
        if (isx) {
            float res = 0.f;
#pragma unroll 1
            for (int g = 0; g < 8; ++g) { float a0 = 0.f, a1 = 0.f;
#pragma unroll
                for (int j = 0; j < 16; ++j) { const v2u w = *(const LAS v2u*)(GW + g * DM + 256 * j + 4 * F.lane); a0 = dot2_bf16(w.x, xp[j].x, a0); a1 = dot2_bf16(w.y, xp[j].y, a1); }
                a0 = wave_sum(a0 + a1); res = (F.lane == g) ? a0 : res; }
            if (F.lane < 8) GATES[(size_t)m * 8 + F.lane] = res + gate_bias;
        }
    }
    P0_ITEMS(1 << 30);
#undef P0_ITEMS
}

__device__ __forceinline__ float log_sigmoid_f(float v) { return fminf(v, 0.f) - log1pf(expf(-fabsf(v))); }
template <int OP> __device__ __forceinline__ void wave_scan128(const LAS float* in, LAS float* out, int lane) {
    const float e0 = in[2 * lane], e1 = in[2 * lane + 1];
    float s = OP ? fmaxf(e0, e1) : (e0 + e1);
#pragma unroll
    for (int o = 1; o < 64; o <<= 1) { const float t = __shfl_up(s, o); if (lane >= o) s = OP ? fmaxf(s, t) : (s + t); }
    float ex = __shfl_up(s, 1);
    if (OP) { const float a = (lane == 0) ? e0 : fmaxf(ex, e0); out[2 * lane] = a; out[2 * lane + 1] = fmaxf(a, e1); }
    else { const float a = (lane == 0) ? e0 : (ex + e0); out[2 * lane] = a; out[2 * lane + 1] = a + e1; }
}

typedef short s16x4 __attribute__((ext_vector_type(4)));
__device__ __forceinline__ s16x4 ds_tr(const LAS unsigned char* p) { return __builtin_bit_cast(s16x4, __builtin_amdgcn_ds_read_tr16_b64_v4i16((LAS s16x4*)p)); }
__device__ __forceinline__ bf16x8 tr_frag(const LAS unsigned char* p0, const LAS unsigned char* p1) { const s16x4 a = ds_tr(p0), b = ds_tr(p1); return __builtin_shufflevector(a, b, 0, 1, 2, 3, 4, 5, 6, 7); }
__device__ __forceinline__ v4u ldg16(const bf16* p) { return *(const GAS v4u*)p; }
__device__ __forceinline__ void stg16(bf16* p, v4u v) { *(GAS v4u*)p = v; }
__device__ __forceinline__ void ws_store16_sc1(const Frame& F, size_t off, v4u v) {
    const __amdgpu_buffer_rsrc_t rsrc = __builtin_amdgcn_make_buffer_rsrc(F.ws, 0, (unsigned)WS_END, 0x00020000);
    __builtin_amdgcn_raw_buffer_store_b128(v, rsrc, (unsigned)off, 0, 16); }
__device__ __forceinline__ v4u zero4() { v4u z; z.x = 0u; z.y = 0u; z.z = 0u; z.w = 0u; return z; }
__device__ __forceinline__ v4u gate_pack(f32x4 a, f32x4 b, float s, v4u z) {
    v4u o;
    o.x = pg8::cvt_pk_bf16(a[0] * s * bf2f(z.x & 0xffffu), a[1] * s * bf2f(z.x >> 16)); o.y = pg8::cvt_pk_bf16(a[2] * s * bf2f(z.y & 0xffffu), a[3] * s * bf2f(z.y >> 16));
    o.z = pg8::cvt_pk_bf16(b[0] * s * bf2f(z.z & 0xffffu), b[1] * s * bf2f(z.z >> 16)); o.w = pg8::cvt_pk_bf16(b[2] * s * bf2f(z.w & 0xffffu), b[3] * s * bf2f(z.w >> 16));
    return o;
}

__device__ __forceinline__ void scan_item(Frame& F, int sl) {
    float* CLOC = WSP(float, WS_CLOC); float* CST = WSP(float, WS_SMALL); float* MPREV = WSP(float, WS_SMALL + 4096);
    const int gt = sl * (NWAVES * 64) + F.tid;
    constexpr int OCT = 257 * 16;
    if (gt < 8 * OCT) {
        const int bh = gt / OCT, off = (gt % OCT) * 8;
        float m = 0.f; f32x4 c0 = {0.f, 0.f, 0.f, 0.f}, c1 = {0.f, 0.f, 0.f, 0.f};
#pragma unroll 8
        for (int c = 0; c < 32; ++c) {
            const int item = bh * 32 + c;
            const float gl = CST[item * 2], ml = CST[item * 2 + 1];
            const GAS f32x4* cp = (const GAS f32x4*)(CLOC + (size_t)item * (257 * 128) + off);
            const f32x4 cl0 = cp[0], cl1 = cp[1];
            v4u o; o.x = pk2(c0[0], c0[1]); o.y = pk2(c0[2], c0[3]); o.z = pk2(c1[0], c1[1]); o.w = pk2(c1[2], c1[3]);
            ws_store16_sc1(F, WS_CPREV + ((size_t)item * (257 * 128) + off) * 2, o);
            if (off == 0) __hip_atomic_store(MPREV + item, m, RLX_AGENT);
            const float mn = fmaxf(gl + m, ml), sp = expf(gl + m - mn), sl2 = expf(ml - mn);
            c0 = c0 * sp + cl0 * sl2; c1 = c1 * sp + cl1 * sl2; m = mn;
        }
    }
    asm volatile("s_waitcnt vmcnt(0)" ::: "memory");
    __syncthreads();
    if (F.tid == 0) __hip_atomic_fetch_add(F.ctl + CW_SCANDONE, 1u, RLX_AGENT);
}

__device__ __forceinline__ void swa_item4(Frame& F, int item) {
    int tid = F.tid; asm volatile("" : "+v"(tid)); const int lane = tid & 63;
    const float* rel_bias = in_ptr(F, 8); const float* sinks = in_ptr(F, 9); bf16* PROJ = WSP(bf16, WS_PROJ); bf16* MIX = WSP(bf16, WS_MIX);
    const int b = item >> 7, n = (item >> 2) & 31, kv = item & 3;
    const int row0 = b * SEQ + n * 128;
    LAS unsigned char* Ks = F.lds;
    LAS unsigned char* Vs = F.lds + 69632;
    LAS float* BT = (LAS float*)(F.lds + 143360);
    const int g = F.wave >> 1, head = kv * 4 + g, l15 = lane & 15, quad = lane >> 4, tq = (lane & 15) >> 2, tp = lane & 3;
    const int qw = (F.wave & 1) * 64;
    bf16x8 qf[2][2][4];
#pragma unroll
    for (int ds = 0; ds < 2; ++ds)
#pragma unroll
        for (int qt = 0; qt < 2; ++qt) { const bf16* qp = PROJ + (size_t)(row0 + qw + 32 * ds + 16 * qt + l15) * NPROJ + C_AQ + head * 128 + 8 * quad;
#pragma unroll
            for (int ks = 0; ks < 4; ++ks) qf[ds][qt][ks] = __builtin_bit_cast(bf16x8, ldg16(qp + 32 * ks)); }
    {   const int gg = tid >> 7, dist = tid & 127; int bucket = dist;
        if (dist >= 16) { const float ratio = (float)dist / 16.0f; const int lg = 16 + (int)(logf(ratio) / logf(8.0f) * 16.0f); bucket = lg < 31 ? lg : 31; }
        BT[gg * 128 + dist] = rel_bias[bucket * 16 + kv * 4 + gg] * 1.4426950408889634f; }
    {   v4u kq[8], vq[8];
#pragma unroll
        for (int it = 0; it < 8; ++it) { const int idx = tid + 512 * it, key = idx >> 4, ch = idx & 15; const bool valid = (n > 0) || (key >= 128);
            kq[it] = zero4(); vq[it] = zero4();
            if (valid) { const bf16* src = PROJ + (size_t)(row0 - 128 + key) * NPROJ + kv * 128 + ch * 8; kq[it] = ldg16(src + C_AK); vq[it] = ldg16(src + C_AV); } }
#pragma unroll
        for (int it = 0; it < 8; ++it) { const int idx = tid + 512 * it, key = idx >> 4, ch = idx & 15;
            *(LAS v4u*)(Ks + key * 272 + ch * 16) = kq[it]; *(LAS v4u*)(Vs + key * 288 + ch * 16) = vq[it]; } }
    __syncthreads();
    ISTAMP(26);
    const float sink = sinks[head];
    const float scale = 0.08838834764831845f;
#pragma unroll
    for (int ds = 0; ds < 2; ++ds) {
        const int q0 = qw + 32 * ds, kbase = q0;
        v4u zz[2][4];
#pragma unroll
        for (int qt = 0; qt < 2; ++qt) { const bf16* zp = PROJ + (size_t)(row0 + q0 + 16 * qt + l15) * NPROJ + C_AZ + head * 128 + 8 * quad;
#pragma unroll
            for (int P2 = 0; P2 < 4; ++P2) zz[qt][P2] = ldg16(zp + 32 * P2); }
        f32x4 st[2][10];
#pragma unroll
        for (int kt = 0; kt < 10; ++kt) { f32x4 a0 = {0.f, 0.f, 0.f, 0.f}, a1 = {0.f, 0.f, 0.f, 0.f}; const LAS unsigned char* kp = Ks + (kbase + 16 * kt + l15) * 272 + 16 * quad;
#pragma unroll
            for (int ks = 0; ks < 4; ++ks) { const bf16x8 kf = ld_frag16(kp + 64 * ks); a0 = MFMA16(kf, qf[ds][0][ks], a0); a1 = MFMA16(kf, qf[ds][1][ks], a1); }
            st[0][kt] = a0; st[1][kt] = a1; }
        if (ds == 0) ISTAMP(27);
        bf16x8 pb[2][5]; float inv[2];
        const float sc2 = scale * 1.4426950408889634f, sink2 = sink * 1.4426950408889634f;
        const LAS float* btl = BT + g * 128 + l15 - 4 * quad;
#pragma unroll
        for (int qt = 0; qt < 2; ++qt) {
            float mx = sink2;
            if (n > 0) {
#pragma unroll
                for (int kt = 0; kt < 10; ++kt) { const int delta = kt - qt;
                    if (delta < 0 || delta > 8) { st[qt][kt] = (f32x4){-INFINITY, -INFINITY, -INFINITY, -INFINITY}; continue; }
#pragma unroll
                    for (int r = 0; r < 4; ++r) { const int e = l15 - 4 * quad - r;
                        float sv = st[qt][kt][r] * sc2 + btl[128 - 16 * delta - r];
                        if (delta == 0) sv = (e < 0) ? sv : -INFINITY;
                        if (delta == 8) sv = (e >= 0) ? sv : -INFINITY;
                        st[qt][kt][r] = sv; mx = fmaxf(mx, sv); } }
            } else {
                const int qi = q0 + 16 * qt + l15;
#pragma unroll
                for (int kt = 0; kt < 10; ++kt)
#pragma unroll
                    for (int r = 0; r < 4; ++r) { const int si = kbase + 16 * kt + 4 * quad + r, dist = qi + 128 - si;
                        const bool ok = (dist >= 0) && (dist < 128) && (si >= 128);
                        const float sv = ok ? st[qt][kt][r] * sc2 + BT[g * 128 + (dist & 127)] : -INFINITY;
                        st[qt][kt][r] = sv; mx = fmaxf(mx, sv); }
            }
            mx = quad_max(mx);
            float sum = 0.f;
#pragma unroll
            for (int kt = 0; kt < 10; ++kt)
#pragma unroll
                for (int r = 0; r < 4; ++r) { const float p = __builtin_amdgcn_exp2f(st[qt][kt][r] - mx); st[qt][kt][r] = p; sum += p; }
            sum = quad_sum(sum) + __builtin_amdgcn_exp2f(sink2 - mx);
            inv[qt] = 1.0f / sum;
#pragma unroll
            for (int kp = 0; kp < 5; ++kp) { const f32x4 p0 = st[qt][2 * kp], p1 = st[qt][2 * kp + 1];
                pb[qt][kp] = mk_frag(pg8::cvt_pk_bf16(p0[0], p0[1]), pg8::cvt_pk_bf16(p0[2], p0[3]), pg8::cvt_pk_bf16(p1[0], p1[1]), pg8::cvt_pk_bf16(p1[2], p1[3])); }
        }
        if (ds == 0) ISTAMP(28);
        const LAS unsigned char* vb = Vs + (kbase + 4 * quad + tq) * 288 + 16 * tp;
#pragma unroll
        for (int P2 = 0; P2 < 4; ++P2) {
            f32x4 o00 = {0.f, 0.f, 0.f, 0.f}, o01 = o00, o10 = o00, o11 = o00;
#pragma unroll
            for (int kp = 0; kp < 5; ++kp) { const LAS unsigned char* va = vb + (32 * kp) * 288 + 64 * P2;
                const bf16x8 v0 = tr_frag(va, va + 16 * 288), v1 = tr_frag(va + 8, va + 16 * 288 + 8);
                o00 = MFMA16(v0, pb[0][kp], o00); o01 = MFMA16(v1, pb[0][kp], o01);
                o10 = MFMA16(v0, pb[1][kp], o10); o11 = MFMA16(v1, pb[1][kp], o11); }
            bf16* op = MIX + (size_t)(row0 + q0 + l15) * DM + head * 128 + 8 * quad + 32 * P2;
            stg16(op, gate_pack(o00, o01, inv[0], zz[0][P2]));
            stg16(op + (size_t)16 * DM, gate_pack(o10, o11, inv[1], zz[1][P2]));
        }
    }
    __syncthreads();
}

__device__ __forceinline__ void cross_item3(Frame& F, int item) {
    int tid = F.tid; asm volatile("" : "+v"(tid)); const int lane = tid & 63;
    bf16* PROJ = WSP(bf16, WS_PROJ); bf16* MKV = WSP(bf16, WS_MKV); bf16* MIX = WSP(bf16, WS_MIX);
    const int b = item >> 7, h = (item >> 5) & 3, qt = item & 31;
    const int l15 = lane & 15, quad = lane >> 4, tq = (lane & 15) >> 2, tp = lane & 3;
    const size_t grow = (size_t)b * SEQ + qt * 128 + F.wave * 16 + l15;
    const bf16* kvsrc = MKV + (size_t)(b * 256) * 2048 + h * 256;
    bf16x8 qf[8];
    { const bf16* qp = PROJ + grow * NPROJ + C_CQ + h * 256 + 8 * quad;
#pragma unroll
      for (int ks = 0; ks < 8; ++ks) qf[ks] = __builtin_bit_cast(bf16x8, ldg16(qp + 32 * ks)); }
    {   v4u t[16];
#pragma unroll
        for (int it = 0; it < 16; ++it) { const int idx = tid + 512 * it, m = idx >> 5, ch = idx & 31; t[it] = ldg16(kvsrc + (size_t)m * 2048 + ch * 8); }
#pragma unroll
        for (int it = 0; it < 16; ++it) { const int idx = tid + 512 * it, m = idx >> 5, ch = idx & 31; *(LAS v4u*)(F.lds + m * 528 + ch * 16) = t[it]; } }
    __syncthreads();
    v4u vt[16];
#pragma unroll
    for (int it = 0; it < 16; ++it) { const int idx = tid + 512 * it, m = idx >> 5, ch = idx & 31; vt[it] = ldg16(kvsrc + 1024 + (size_t)m * 2048 + ch * 8); }
    bf16x8 pb[8]; float inv;
    {
        f32x4 st[16];
#pragma unroll
        for (int kt = 0; kt < 16; ++kt) { f32x4 a = {0.f, 0.f, 0.f, 0.f}; const LAS unsigned char* kp = F.lds + (16 * kt + l15) * 528 + 16 * quad;
#pragma unroll
            for (int ks = 0; ks < 8; ++ks) a = MFMA16(ld_frag16(kp + 64 * ks), qf[ks], a);
            st[kt] = a; }
        float mx = -INFINITY;
#pragma unroll
        for (int kt = 0; kt < 16; ++kt)
#pragma unroll
            for (int r = 0; r < 4; ++r) { const float sc = st[kt][r] * 0.0625f; st[kt][r] = sc; mx = fmaxf(mx, sc); }
        mx = quad_max(mx);
        float sum = 0.f;
#pragma unroll
        for (int kt = 0; kt < 16; ++kt)
#pragma unroll
            for (int r = 0; r < 4; ++r) { const float p = fast_exp(st[kt][r] - mx); st[kt][r] = p; sum += p; }
        sum = quad_sum(sum);
        inv = 1.0f / sum;
#pragma unroll
        for (int kp = 0; kp < 8; ++kp) { const f32x4 p0 = st[2 * kp], p1 = st[2 * kp + 1];
            pb[kp] = mk_frag(pg8::cvt_pk_bf16(p0[0], p0[1]), pg8::cvt_pk_bf16(p0[2], p0[3]), pg8::cvt_pk_bf16(p1[0], p1[1]), pg8::cvt_pk_bf16(p1[2], p1[3])); }
    }
    __syncthreads();
#pragma unroll
    for (int it = 0; it < 16; ++it) { const int idx = tid + 512 * it, m = idx >> 5, ch = idx & 31; *(LAS v4u*)(F.lds + m * 544 + ch * 16) = vt[it]; }
    const bf16* zp = PROJ + grow * NPROJ + C_CZ + h * 256 + 8 * quad; bf16* op = MIX + grow * DM + 3072 + h * 256 + 8 * quad;
    v4u zz[8];
#pragma unroll
    for (int P2 = 0; P2 < 8; ++P2) zz[P2] = ldg16(zp + 32 * P2);
    __syncthreads();
    const LAS unsigned char* vb = F.lds + (4 * quad + tq) * 544 + 16 * tp;
#pragma unroll
    for (int P2 = 0; P2 < 8; ++P2) {
        f32x4 o0 = {0.f, 0.f, 0.f, 0.f}, o1 = {0.f, 0.f, 0.f, 0.f};
#pragma unroll
        for (int kp = 0; kp < 8; ++kp) { const LAS unsigned char* va = vb + (32 * kp) * 544 + 64 * P2;
            o0 = MFMA16(tr_frag(va, va + 16 * 544), pb[kp], o0);
            o1 = MFMA16(tr_frag(va + 8, va + 16 * 544 + 8), pb[kp], o1); }
        stg16(op + 32 * P2, gate_pack(o0, o1, inv, zz[P2]));
    }
    __syncthreads();
}

__device__ __forceinline__ void conv8(const v4u (&r)[4], const f32x4 (&w)[4][2], const f32x4 (&cb)[2], float oscale, v4u& o) {
    float y[8];
#pragma unroll
    for (int e = 0; e < 8; ++e) y[e] = cb[e >> 2][e & 3];
#pragma unroll
    for (int j = 0; j < 4; ++j) { const unsigned q[4] = {r[j].x, r[j].y, r[j].z, r[j].w};
#pragma unroll
        for (int e = 0; e < 8; ++e) { const float xv = (e & 1) ? bf2f(q[e >> 1] >> 16) : bf2f(q[e >> 1] & 0xffffu); y[e] += w[j][e >> 2][e & 3] * xv; } }
#pragma unroll
    for (int e = 0; e < 8; ++e) y[e] = y[e] * sigmoidf_(y[e]) * oscale;
    o.x = pk2(y[0], y[1]); o.y = pk2(y[2], y[3]); o.z = pk2(y[4], y[5]); o.w = pk2(y[6], y[7]);
}
__device__ __forceinline__ void cloc_item3(Frame& F, int item) {
    int tid = F.tid; asm volatile("" : "+v"(tid)); const int lane = tid & 63;
    const float* conv_w = in_ptr(F, 3); const float* conv_b = in_ptr(F, 4); bf16* PROJ = WSP(bf16, WS_PROJ); float* GATES = WSP(float, WS_GATES); float* CST = WSP(float, WS_SMALL);
    const int b = item >> 7, h = (item >> 5) & 3, c = item & 31;
    const int r0 = b * SEQ + c * 128;
    LAS unsigned char* V = F.lds; LAS unsigned char* KQ = F.lds + 69632;
    LAS float* LI = (LAS float*)(F.lds + 106496); LAS float* LF = LI + 128; LAS float* BB = LF + 128; LAS float* WW = BB + 128;
    {   v4u vt[8];
#pragma unroll
        for (int it = 0; it < 8; ++it) { const int idx = tid + 512 * it, l = idx >> 5, ch = idx & 31; vt[it] = ldg16(PROJ + (size_t)(r0 + l) * NPROJ + C_MV + h * 256 + ch * 8); }
        float li = 0.f, fp = 0.f;
        if (tid < 128) { li = GATES[(size_t)(r0 + tid) * 8 + h]; fp = GATES[(size_t)(r0 + tid) * 8 + 4 + h]; }
#pragma unroll
        for (int it = 0; it < 8; ++it) { const int idx = tid + 512 * it, l = idx >> 5, ch = idx & 31; *(LAS v4u*)(V + l * 544 + ch * 16) = vt[it]; }
        if (tid < 128) { v4u o1 = zero4(); o1.x = 0x3F80u; *(LAS v4u*)(V + tid * 544 + 512) = o1; *(LAS v4u*)(V + tid * 544 + 528) = zero4(); LI[tid] = li; LF[tid] = log_sigmoid_f(fp); }
    }
    __syncthreads();
    if (F.wave == 0) {
        wave_scan128<0>(LF, BB, lane);
        const float gl = __shfl(BB[2 * lane + 1], 63);
        const float a0 = gl - BB[2 * lane] + LI[2 * lane], a1 = gl - BB[2 * lane + 1] + LI[2 * lane + 1];
        float mx = fmaxf(a0, a1);
#pragma unroll
        for (int o = 1; o < 64; o <<= 1) mx = fmaxf(mx, __shfl_xor(mx, o));
        WW[2 * lane] = expf(a0 - mx); WW[2 * lane + 1] = expf(a1 - mx);
        if (lane == 0) { __hip_atomic_store(CST + item * 2, gl, RLX_AGENT); __hip_atomic_store(CST + item * 2 + 1, mx, RLX_AGENT); }
    }
    v4u kpk[4];
    {   const int ch = tid & 15;
        f32x4 wq[4][2], wk[4][2], bq[2], bk[2];
#pragma unroll
        for (int j = 0; j < 4; ++j) { const GAS f32x4* pq = (const GAS f32x4*)(conv_w + j * 1024 + h * 128 + ch * 8); const GAS f32x4* pk = (const GAS f32x4*)(conv_w + j * 1024 + 512 + h * 128 + ch * 8);
            wq[j][0] = pq[0]; wq[j][1] = pq[1]; wk[j][0] = pk[0]; wk[j][1] = pk[1]; }
        { const GAS f32x4* pq = (const GAS f32x4*)(conv_b + h * 128 + ch * 8); const GAS f32x4* pk = (const GAS f32x4*)(conv_b + 512 + h * 128 + ch * 8); bq[0] = pq[0]; bq[1] = pq[1]; bk[0] = pk[0]; bk[1] = pk[1]; }
#pragma unroll
        for (int i = 0; i < 4; ++i) { const int l = (tid >> 4) + 32 * i;
            v4u rq[4], rk[4];
#pragma unroll
            for (int j = 0; j < 4; ++j) { const int rr = l - 3 + j; rq[j] = zero4(); rk[j] = zero4();
                if (c > 0 || rr >= 0) { const bf16* src = PROJ + (size_t)(r0 + rr) * NPROJ + h * 128 + ch * 8; rq[j] = ldg16(src + C_MQ); rk[j] = ldg16(src + C_MK); } }
            v4u oq; conv8(rq, wq, bq, 1.0f, oq); conv8(rk, wk, bk, 0.08838834764831845f, kpk[i]);
            ws_store16_sc1(F, WS_MQK + ((size_t)(r0 + l) * 1024 + h * 128 + ch * 8) * 2, oq);
            ws_store16_sc1(F, WS_MQK + ((size_t)(r0 + l) * 1024 + 512 + h * 128 + ch * 8) * 2, kpk[i]); }
    }
    __syncthreads();
    {   const int ch = tid & 15;
#pragma unroll
        for (int i = 0; i < 4; ++i) { const int l = (tid >> 4) + 32 * i; const float w = WW[l]; const v4u k = kpk[i]; v4u o;
            o.x = pk2(bf2f(k.x & 0xffffu) * w, bf2f(k.x >> 16) * w); o.y = pk2(bf2f(k.y & 0xffffu) * w, bf2f(k.y >> 16) * w);
            o.z = pk2(bf2f(k.z & 0xffffu) * w, bf2f(k.z >> 16) * w); o.w = pk2(bf2f(k.w & 0xffffu) * w, bf2f(k.w >> 16) * w);
            *(LAS v4u*)(KQ + l * 288 + ch * 16) = o; } }
    __syncthreads();
    {   const int l15 = lane & 15, quad = lane >> 4, tq = (lane & 15) >> 2, tp = lane & 3;
        const LAS unsigned char* kb = KQ + (8 * quad + tq) * 288 + 8 * tp;
        const LAS unsigned char* vb = V + (8 * quad + tq) * 544 + 8 * tp;
        for (int vt = F.wave; vt < 17; vt += 8) {
            bf16x8 bfr[4];
#pragma unroll
            for (int ks = 0; ks < 4; ++ks) { const LAS unsigned char* p = vb + (32 * ks) * 544 + 32 * vt; bfr[ks] = tr_frag(p, p + 4 * 544); }
            const int v = 16 * vt + l15;
#pragma unroll
            for (int nt = 0; nt < 8; ++nt) { f32x4 a = {0.f, 0.f, 0.f, 0.f};
#pragma unroll
                for (int ks = 0; ks < 4; ++ks) { const LAS unsigned char* p = kb + (32 * ks) * 288 + 32 * nt; a = MFMA16(tr_frag(p, p + 4 * 288), bfr[ks], a); }
                if (v < 257) ws_store16_sc1(F, WS_CLOC + ((size_t)item * (257 * 128) + (size_t)v * 128 + 16 * nt + 4 * quad) * 4, __builtin_bit_cast(v4u, a)); }
        }
    }
    asm volatile("s_waitcnt vmcnt(0)" ::: "memory");
    __syncthreads();
    if (tid == 0) __hip_atomic_fetch_add(F.ctl + CW_CLOCDONE, 1u, RLX_AGENT);
}

__device__ __forceinline__ void mout_item3(Frame& F, int item) {
    int tid = F.tid; asm volatile("" : "+v"(tid)); const int lane = tid & 63;
    const float* m_norm_g = in_ptr(F, 7); bf16* PROJ = WSP(bf16, WS_PROJ); bf16* MQK = WSP(bf16, WS_MQK); bf16* CPREV = WSP(bf16, WS_CPREV); float* GATES = WSP(float, WS_GATES); float* MPREV = WSP(float, WS_SMALL + 4096); bf16* MIX = WSP(bf16, WS_MIX);
    const int b = item >> 7, h = (item >> 5) & 3, c = item & 31;
    const int r0 = b * SEQ + c * 128;
    LAS unsigned char* V = F.lds; LAS unsigned char* CP = F.lds + 69632;
    LAS float* LI = (LAS float*)(F.lds + 143616); LAS float* LF = LI + 128; LAS float* BB = LF + 128; LAS float* UU = BB + 128; LAS float* MM = UU + 128;
    const float mprev = MPREV[item];
    {   v4u vt[8], ct[9];
#pragma unroll
        for (int it = 0; it < 8; ++it) { const int idx = tid + 512 * it, l = idx >> 5, ch = idx & 31; vt[it] = ldg16(PROJ + (size_t)(r0 + l) * NPROJ + C_MV + h * 256 + ch * 8); }
#pragma unroll
        for (int it = 0; it < 9; ++it) { const int idx = tid + 512 * it, row = idx >> 4, ch = idx & 15; ct[it] = zero4();
            if (row < 257) ct[it] = ldg16(CPREV + (size_t)item * (257 * 128) + row * 128 + ch * 8); }
        float li = 0.f, fp = 0.f;
        if (tid < 128) { li = GATES[(size_t)(r0 + tid) * 8 + h]; fp = GATES[(size_t)(r0 + tid) * 8 + 4 + h]; }
#pragma unroll
        for (int it = 0; it < 8; ++it) { const int idx = tid + 512 * it, l = idx >> 5, ch = idx & 31; *(LAS v4u*)(V + l * 544 + ch * 16) = vt[it]; }
#pragma unroll
        for (int it = 0; it < 9; ++it) { const int idx = tid + 512 * it, row = idx >> 4, ch = idx & 15; if (row < 272) *(LAS v4u*)(CP + row * 272 + ch * 16) = ct[it]; }
        if (tid < 128) { v4u o1 = zero4(); o1.x = 0x3F80u; *(LAS v4u*)(V + tid * 544 + 512) = o1; *(LAS v4u*)(V + tid * 544 + 528) = zero4(); LI[tid] = li; LF[tid] = log_sigmoid_f(fp); }
    }
    __syncthreads();
    const int l15 = lane & 15, quad = lane >> 4, tq = (lane & 15) >> 2, tp = lane & 3, t0 = 16 * F.wave;
    const int t = t0 + l15;
    const size_t grow = (size_t)(r0 + t);
    bf16x8 qf[4], kf[8][4];
    { const bf16* qp = MQK + grow * 1024 + h * 128 + 8 * quad;
#pragma unroll
      for (int ks = 0; ks < 4; ++ks) qf[ks] = __builtin_bit_cast(bf16x8, ldg16(qp + 32 * ks)); }
#pragma unroll
    for (int st = 0; st < 8; ++st) { const bf16* kp = MQK + (size_t)(r0 + 16 * st + l15) * 1024 + 512 + h * 128 + 8 * quad;
#pragma unroll
        for (int ks = 0; ks < 4; ++ks) kf[st][ks] = __builtin_bit_cast(bf16x8, ldg16(kp + 32 * ks)); }
    if (F.wave == 0) {
        wave_scan128<0>(LF, BB, lane);
        UU[2 * lane] = LI[2 * lane] - BB[2 * lane]; UU[2 * lane + 1] = LI[2 * lane + 1] - BB[2 * lane + 1];
        wave_scan128<1>(UU, MM, lane);
        MM[2 * lane] = fmaxf(MM[2 * lane], mprev); MM[2 * lane + 1] = fmaxf(MM[2 * lane + 1], mprev);
    }
    __syncthreads();
    const float Mt = MM[t], mt = BB[t] + Mt;
    bf16x8 sb[4], qb[4];
    {
        f32x4 sT[8];
#pragma unroll
        for (int st = 0; st < 8; ++st) { f32x4 a = {0.f, 0.f, 0.f, 0.f};
#pragma unroll
            for (int ks = 0; ks < 4; ++ks) a = MFMA16(kf[st][ks], qf[ks], a);
#pragma unroll
            for (int r = 0; r < 4; ++r) { const int s = 16 * st + 4 * quad + r; a[r] = (s <= t) ? a[r] * fast_exp(UU[s] - Mt) : 0.f; }
            sT[st] = a; }
#pragma unroll
        for (int kp = 0; kp < 4; ++kp) { const f32x4 p0 = sT[2 * kp], p1 = sT[2 * kp + 1];
            sb[kp] = mk_frag(pg8::cvt_pk_bf16(p0[0], p0[1]), pg8::cvt_pk_bf16(p0[2], p0[3]), pg8::cvt_pk_bf16(p1[0], p1[1]), pg8::cvt_pk_bf16(p1[2], p1[3])); }
        const float wi = fast_exp(mprev - Mt);
#pragma unroll
        for (int ks = 0; ks < 4; ++ks) { const v4u q = __builtin_bit_cast(v4u, qf[ks]);
            qb[ks] = mk_frag(pg8::cvt_pk_bf16(bf2f(q.x & 0xffffu) * wi, bf2f(q.x >> 16) * wi), pg8::cvt_pk_bf16(bf2f(q.y & 0xffffu) * wi, bf2f(q.y >> 16) * wi),
                             pg8::cvt_pk_bf16(bf2f(q.z & 0xffffu) * wi, bf2f(q.z >> 16) * wi), pg8::cvt_pk_bf16(bf2f(q.w & 0xffffu) * wi, bf2f(q.w >> 16) * wi)); }
    }
    const bf16* op = PROJ + grow * NPROJ + C_MO + h * 256 + 8 * quad; const bf16* zp = PROJ + grow * NPROJ + C_MZ + h * 256 + 8 * quad;
    v4u og[8], zz[8];
#pragma unroll
    for (int P2 = 0; P2 < 8; ++P2) { og[P2] = ldg16(op + 32 * P2); zz[P2] = ldg16(zp + 32 * P2); }
    const LAS unsigned char* vb = V + (4 * quad + tq) * 544 + 16 * tp;
    const LAS unsigned char* cb = CP + (8 * (l15 >> 2) + (l15 & 3)) * 272 + 16 * quad;
    f32x4 num[16]; float den;
    {   f32x4 a = {0.f, 0.f, 0.f, 0.f};
        const LAS unsigned char* vd = V + (4 * quad + tq) * 544 + 512 + 8 * tp; const LAS unsigned char* cd = CP + (256 + l15) * 272 + 16 * quad;
#pragma unroll
        for (int kp = 0; kp < 4; ++kp) { const LAS unsigned char* p = vd + (32 * kp) * 544; a = MFMA16(tr_frag(p, p + 16 * 544), sb[kp], a); }
#pragma unroll
        for (int ks = 0; ks < 4; ++ks) a = MFMA16(ld_frag16(cd + 64 * ks), qb[ks], a);
        den = __shfl(a[0], l15); }
#pragma unroll
    for (int P2 = 0; P2 < 8; ++P2)
#pragma unroll
        for (int hf = 0; hf < 2; ++hf) { f32x4 a = {0.f, 0.f, 0.f, 0.f};
#pragma unroll
            for (int kp = 0; kp < 4; ++kp) { const LAS unsigned char* p = vb + (32 * kp) * 544 + 64 * P2 + 8 * hf; a = MFMA16(tr_frag(p, p + 16 * 544), sb[kp], a); }
            const LAS unsigned char* cp = cb + (32 * P2 + 4 * hf) * 272;
#pragma unroll
            for (int ks = 0; ks < 4; ++ks) a = MFMA16(ld_frag16(cp + 64 * ks), qb[ks], a);
            num[2 * P2 + hf] = a; }
    const float inv = 1.0f / fmaxf(fabsf(den), expf(-mt));
    float s = 0.f;
#pragma unroll
    for (int P2 = 0; P2 < 8; ++P2) { const v4u o = og[P2];
        f32x4& a = num[2 * P2]; f32x4& bq = num[2 * P2 + 1];
        a[0] *= inv * bf2f(o.x & 0xffffu); a[1] *= inv * bf2f(o.x >> 16); a[2] *= inv * bf2f(o.y & 0xffffu); a[3] *= inv * bf2f(o.y >> 16);
        bq[0] *= inv * bf2f(o.z & 0xffffu); bq[1] *= inv * bf2f(o.z >> 16); bq[2] *= inv * bf2f(o.w & 0xffffu); bq[3] *= inv * bf2f(o.w >> 16);
        s += (a[0] + a[1]) + (a[2] + a[3]) + (bq[0] + bq[1]) + (bq[2] + bq[3]); }
    const float mean = quad_sum(s) * (1.0f / 256.0f);
    float q2 = 0.f;
#pragma unroll
    for (int i = 0; i < 16; ++i) { num[i] = num[i] - mean; q2 += (num[i][0] * num[i][0] + num[i][1] * num[i][1]) + (num[i][2] * num[i][2] + num[i][3] * num[i][3]); }
    const float rstd = 1.0f / sqrtf(quad_sum(q2) * (1.0f / 256.0f) + HEAD_NORM_EPS);
    const float* ng = m_norm_g + h * 256 + 8 * quad; bf16* mp = MIX + grow * DM + 2048 + h * 256 + 8 * quad;
#pragma unroll
    for (int P2 = 0; P2 < 8; ++P2) {
        const f32x4 g0 = *(const GAS f32x4*)(ng + 32 * P2), g1 = *(const GAS f32x4*)(ng + 32 * P2 + 4);
        stg16(mp + 32 * P2, gate_pack(num[2 * P2] * g0, num[2 * P2 + 1] * g1, rstd, zz[P2])); }
    __syncthreads();
}

__device__ __forceinline__ void ln_phase(Frame& F, float inject) {
    const float* x = in_ptr(F, 0); const float* ln_g = in_ptr(F, 12); const float* ln_b = in_ptr(F, 13); float* out = out_ptr(F); bf16* Y = WSP(bf16, WS_Y);
    const int gw = F.vcu * NWAVES + F.wave, NGW = F.G * NWAVES;
    for (int m = gw; m < MROWS; m += NGW) {
        const GAS f32x4* xr = (const GAS f32x4*)(x + (size_t)m * DM) + F.lane;
        const GAS v2u* yr = (const GAS v2u*)(Y + (size_t)m * DM) + F.lane;
        f32x4 v[16]; float s = 0.f;
#pragma unroll
        for (int j = 0; j < 16; ++j) { const f32x4 xv = xr[64 * j]; const v2u yv = yr[64 * j];
            v[j].x = DEEPNORM_ALPHA * xv.x + bf2f(yv.x & 0xffffu); v[j].y = DEEPNORM_ALPHA * xv.y + bf2f(yv.x >> 16);
            v[j].z = DEEPNORM_ALPHA * xv.z + bf2f(yv.y & 0xffffu); v[j].w = DEEPNORM_ALPHA * xv.w + bf2f(yv.y >> 16);
            s += (v[j].x + v[j].y) + (v[j].z + v[j].w); }
        const float mean = wave_sum(s) * (1.0f / DM); float s2 = 0.f;
#pragma unroll
        for (int j = 0; j < 16; ++j) { v[j] = v[j] - mean; s2 += (v[j].x * v[j].x + v[j].y * v[j].y) + (v[j].z * v[j].z + v[j].w * v[j].w); }
        const float rstd = 1.0f / sqrtf(wave_sum(s2) * (1.0f / DM) + LN_EPS);
        GAS f32x4* orow = (GAS f32x4*)(out + (size_t)m * DM) + F.lane;
        const GAS f32x4* gr = (const GAS f32x4*)ln_g + F.lane; const GAS f32x4* br = (const GAS f32x4*)ln_b + F.lane;
        const float inj = (m == gw) ? inject : 0.f;
#pragma unroll
        for (int j = 0; j < 16; ++j) orow[64 * j] = v[j] * rstd * gr[64 * j] + br[64 * j] + inj;
    }
}

#ifndef MK_N_LAUNCHES
#define MK_N_LAUNCHES 1
#endif
constexpr int N_PHASES = 4;
struct Args { const float* in[14]; float* out; unsigned char* ws; int ph_lo, ph_hi; };
__global__ void __launch_bounds__(NWAVES * 64, 2) hymba_fwd(Args args) {
    extern __shared__ __attribute__((aligned(16))) unsigned char lds[];
    Frame F;
    F.lds = (LAS unsigned char*)lds;
    F.MISC = (volatile LAS unsigned*)(F.lds + MISC_OFF);
    F.tid = threadIdx.x; F.lane = F.tid & 63; F.wave = __builtin_amdgcn_readfirstlane(F.tid >> 6);
    F.G = gridDim.x; { const int bx = blockIdx.x; F.vcu = (F.G % 8 == 0) ? (bx % 8) * (F.G / 8) + bx / 8 : bx; }
    F.ws = args.ws; F.ctl = (gu32*)(args.ws + WS_CTL); F.kargs = (const CAS unsigned char*)__builtin_amdgcn_kernarg_segment_ptr();
    if (F.tid < 64) ((LAS unsigned*)(F.lds + MISC_OFF))[F.tid] = 0u;
    __syncthreads();
    const int lo = args.ph_lo, hi = args.ph_hi;
#ifdef PROBE_A
#define STAMP(k) do { __syncthreads(); if (F.tid == 0) F.MISC[20 + (k)] = (unsigned)__builtin_amdgcn_s_memrealtime(); __syncthreads(); } while (0)
#else
#define STAMP(k) do { } while (0)
#endif
    STAMP(0);
    XcdBarrier bar; bar.bar = (unsigned*)(F.ctl + CW_BAR); bar.x = 0; bar.st = nullptr;
    if (hi - lo > 1) bar = xcd_barrier_post((unsigned*)(F.ctl + CW_BAR), F.MISC + 8);
#ifdef ONLY_PHASE
#define IN(k) ((k) == ONLY_PHASE)
#else
#define IN(k) (lo <= (k) && (k) < hi)
#endif
#define BOTH(k) (IN(k) && IN((k) + 1))
    if (IN(0)) { p0_prologue(F); STAMP(10); if (BOTH(0)) xcd_barrier(bar); }
    STAMP(1);
    if (IN(1)) {
        gu32* early = F.ctl + CW_EARLY; gu32* qhead = F.ctl + CW_QHEAD;
        {   pg8::Gemm g{WSP(bf16, WS_ACAT), WSP(bf16, WS_BTCAT), MROWS + MEMROWS, NPROJ + 2048, DM}; pg8::InProjOrder S; S.G = F.G; S.c = (int)blockIdx.x; S.early = (unsigned*)early;
            pg8::EpiProj E{WSP(bf16, WS_PROJ), NPROJ, WSP(bf16, WS_MKV), 2048};
            pg8::gemm_phase<pg8::EpiProj, pg8::InProjOrder, false, true>(F.lds, g, S, E); }
        STAMP(2);
        constexpr int Q_W = 128, Q_CLOC = Q_W + 256, Q_SWA1 = Q_CLOC + 64, Q_SCAN = Q_SWA1 + 65, Q_SWA2 = Q_SCAN + 192, Q_CROSS = Q_SWA2 + 256, Q_MOUT = Q_CROSS + 256, Q_END = Q_MOUT;
        int acq = 0;
        for (;;) {
            if (F.tid == 0) F.MISC[16] = __hip_atomic_fetch_add(qhead, 1u, RLX_AGENT);
            __syncthreads();
            const int q = (int)F.MISC[16];
            __syncthreads();
            if (q >= Q_END) break;
            const int need = q < Q_W ? 0 : (q < Q_SWA1 ? 1 : (q < Q_SCAN ? 2 : (q < Q_CROSS ? 1 : 3)));
            if (acq < need) { if (need == 3) STAMP(14); if (need == 2) STAMP(16);
                if (F.tid == 0) {
                    gu32* w = need == 1 ? early : (need == 2 ? F.ctl + CW_CLOCDONE : F.ctl + CW_SCANDONE);
                    const unsigned want = need == 1 ? (unsigned)F.G * NWAVES : (need == 2 ? 256u : 65u); unsigned sp = 0;
                    while (__hip_atomic_load(w, RLX_AGENT) < want) { __builtin_amdgcn_s_sleep(4); if (++sp > (1u << 23)) break; }
                    if (need == 3) while (__hip_atomic_load(F.ctl + CW_LATE, RLX_AGENT) < 144u * NWAVES) { __builtin_amdgcn_s_sleep(4); if (++sp > (1u << 23)) break; }
                    __builtin_amdgcn_fence(__ATOMIC_ACQUIRE, "agent"); asm volatile("s_waitcnt vmcnt(0)" ::: "memory"); }
                __syncthreads();
                acq = need;
                if (need == 1) STAMP(3); if (need == 3) STAMP(15); if (need == 2) STAMP(17);
            }
            if (q < Q_W) wout_item(F, q);
            else if (q < Q_CLOC) cloc_item3(F, q - Q_W);
            else if (q < Q_SWA1) swa_item4(F, q - Q_CLOC);
            else if (q < Q_SCAN) scan_item(F, q - Q_SWA1);
            else if (q < Q_SWA2) swa_item4(F, q - Q_SCAN + 64);
            else if (q < Q_CROSS) cross_item3(F, q - Q_SWA2);
            else mout_item3(F, q - Q_CROSS);
        }
        STAMP(4);
        if (BOTH(1)) xcd_barrier(bar);
    }
    STAMP(5); STAMP(6); STAMP(7);
    if (IN(2)) {
        pg8::Gemm g{WSP(bf16, WS_MIX), WSP(bf16, WS_WOT), MROWS, DM, DM}; pg8::StaticOrder S; S.init(MROWS, DM, F.G, (int)blockIdx.x);
        pg8::EpiY E{WSP(bf16, WS_Y), DM};
        pg8::gemm_phase<pg8::EpiY, pg8::StaticOrder, false, true>(F.lds, g, S, E);
        STAMP(13);
        if (BOTH(2)) xcd_barrier(bar);
    }
    STAMP(8);
    float inject = 0.f;
#ifdef PROBE_A
    STAMP(9);
    if ((int)blockIdx.x == PROBE_BLK) { const unsigned dt = F.MISC[20 + PROBE_B] - F.MISC[20 + PROBE_A]; inject = sqrtf(5.12e-3f * ((float)dt * 0.01f) / (float)(PROBE_FULL)); }
#endif
    if (IN(3)) ln_phase(F, inject);
#undef IN
#undef BOTH
}

extern "C" void kernel_launch(void* const* d_in, const int* in_sizes, int n_in, void* d_out, int out_size, void* d_ws, size_t ws_size, hipStream_t stream) {
    static int grid = 0;
    if (grid == 0) {
        if (n_in != 14 || in_sizes[0] != MROWS * DM || out_size != MROWS * DM || ws_size < WS_END) { fprintf(stderr, "kernel_launch: unexpected shapes (n_in %d, in0 %d, out %d, ws %zu); nothing launched\n", n_in, n_in > 0 ? in_sizes[0] : -1, out_size, ws_size); grid = -1; return; }
        int dev = 0, cus = 0, per_cu = 0;
        if (hipGetDevice(&dev) != hipSuccess || hipDeviceGetAttribute(&cus, hipDeviceAttributeMultiprocessorCount, dev) != hipSuccess) { grid = -1; return; }
        if (hipFuncSetAttribute((const void*)hymba_fwd, hipFuncAttributeMaxDynamicSharedMemorySize, LDS_BYTES) != hipSuccess) { fprintf(stderr, "kernel_launch: hipFuncSetAttribute failed\n"); grid = -1; return; }
        if (hipOccupancyMaxActiveBlocksPerMultiprocessor(&per_cu, (const void*)hymba_fwd, NWAVES * 64, LDS_BYTES) != hipSuccess || per_cu < 1) { fprintf(stderr, "kernel_launch: occupancy query says %d blocks per CU; nothing launched\n", per_cu); (void)hipGetLastError(); grid = -1; return; }
        grid = cus;
    }
    if (grid < 0) return;
    (void)hipMemsetAsync((char*)d_ws + WS_CTL, 0, CTL_ZERO_BYTES, stream);
    Args a{};
    for (int i = 0; i < 14; ++i) a.in[i] = (const float*)d_in[i];
    a.out = (float*)d_out; a.ws = (unsigned char*)d_ws;
#if MK_N_LAUNCHES == 1
    a.ph_lo = 0; a.ph_hi = N_PHASES;
    void* kargs[] = {&a};
    const hipError_t le = hipLaunchCooperativeKernel((const void*)hymba_fwd, dim3(grid), dim3(NWAVES * 64), kargs, LDS_BYTES, stream);
    if (le != hipSuccess) fprintf(stderr, "kernel_launch: cooperative launch failed: %s (grid %d)\n", hipGetErrorString(le), grid);
#ifdef PROBE_EXTRA
    a.ph_lo = PROBE_EXTRA; a.ph_hi = PROBE_EXTRA + 1; hipLaunchKernelGGL(hymba_fwd, dim3(grid), dim3(NWAVES * 64), LDS_BYTES, stream, a);
#endif
#else
    for (int p = 0; p < N_PHASES; ++p) { a.ph_lo = p; a.ph_hi = p + 1; hipLaunchKernelGGL(hymba_fwd, dim3(grid), dim3(NWAVES * 64), LDS_BYTES, stream, a); }
#endif
}
```

```cpp
#include <hip/hip_runtime.h>
#include <cstdio>
#include <cstdint>
#include <cstddef>
namespace pg8 {
#define PG8_LAS __attribute__((address_space(3)))
typedef unsigned short bf16_t;
typedef short bf16x8 __attribute__((ext_vector_type(8)));
typedef float f32x4 __attribute__((ext_vector_type(4)));
typedef unsigned u32x4 __attribute__((ext_vector_type(4)));
constexpr int BM = 256, BK = 64, HALF = 128, HTB = HALF * BK * 2  , STAGE_BYTES = 8 * HTB, NXCD = 8, WGM = 8;

__host__ __device__ __forceinline__ int lds_byte(int r, int c) { const int st = (r >> 4) * 2 + (c >> 5), rr = r & 15, cc = c & 31, ob = rr * 64 + cc * 2; return st * 1024 + (ob ^ (((ob >> 9) & 1) << 5)); }
__host__ __device__ __forceinline__ void stage_rc(int b, int& R, int& C) { const int st = b / 1024, sb = b % 1024, swz = sb ^ (((sb >> 9) & 1) << 5); R = (st >> 1) * 16 + swz / 64; C = (st & 1) * 32 + (swz % 64) / 2; }
__host__ __device__ __forceinline__ int perm32(int rho) { const int n = rho >> 4, i = rho & 15; return 8 * (i >> 2) + 4 * n + (i & 3); }

struct Unit { int pm, pn, tag; };
struct Gemm { const bf16_t* A; const bf16_t* Bt; int M, N, K; };

struct StaticOrder {
    int nM, nN, nwg, G, c;
    __host__ __device__ void init(int M, int N, int G_, int c_) { nM = M / BM; nN = N / BM; nwg = nM * nN; G = G_; c = c_; }
    __host__ __device__ bool next(int i, Unit& u) const {
        const long L = (long)i * G + c; if (L >= nwg) return false;
        int wgid = (int)L; { const int q = nwg / NXCD, r = nwg % NXCD, xcd = wgid % NXCD, off = wgid / NXCD; wgid = (xcd < r ? xcd * (q + 1) : r * (q + 1) + (xcd - r) * q) + off; }
        const int nig = WGM * nN, gid = wgid / nig, fm = gid * WGM, gsz = (nM - fm) < WGM ? (nM - fm) : WGM;
        u.pm = fm + ((wgid % nig) % gsz); u.pn = (wgid % nig) / gsz; u.tag = 0; return true;
    }
    __device__ __forceinline__ void a_ready(const Unit&) const {}
    __device__ __forceinline__ void done(const Unit&) const {}
};
__device__ __forceinline__ unsigned cvt_pk_bf16(float lo, float hi) { unsigned r; asm volatile("v_cvt_pk_bf16_f32 %0, %1, %2" : "=v"(r) : "v"(lo), "v"(hi)); return r; }
typedef float f32x2 __attribute__((ext_vector_type(2)));
__device__ __forceinline__ float sigmoid_f(float v) { return __builtin_amdgcn_rcpf(1.0f + __builtin_amdgcn_exp2f(-1.4426950408889634f * v)); }
struct EpiProj {
    static constexpr bool PERM = true, AFTER_DRAIN = false;
    bf16_t* P; int ldp; bf16_t* MKV; int ldm;
    __device__ __forceinline__ void operator()(const f32x4 (&acc)[2][2][4][2], const Unit& u, int wr, int wc, int fr, int fq) const {
        bf16_t* tbase; unsigned tbytes; unsigned boff; int ld; int act = 0;
        if (u.pm < 32) { tbase = P; tbytes = 8192u * 11264u * 2u; boff = (unsigned)(u.pm * BM) * (unsigned)ldp + (unsigned)(u.pn * BM); ld = ldp; const int pn = u.pn;
            act = ((pn >= 12 && pn < 20) || (pn >= 32 && pn < 36) || pn >= 40) ? 1 : ((pn >= 28 && pn < 32) ? 2 : 0); }
        else { tbase = MKV; tbytes = 512u * 2048u * 2u; boff = (unsigned)((u.pm - 32) * BM) * (unsigned)ldm + (unsigned)((u.pn - 44) * BM); ld = ldm; }
        const __amdgpu_buffer_rsrc_t rsrc = __builtin_amdgcn_make_buffer_rsrc(tbase, 0, tbytes, 0x00020000);
        const int row0 = wr * 64 + fr, col0 = wc * 32 + 8 * fq;
#pragma unroll
        for (int ai = 0; ai < 2; ++ai)
#pragma unroll
            for (int m = 0; m < 4; ++m) { const unsigned rowoff = (boff + (unsigned)(row0 + ai * HALF + m * 16) * (unsigned)ld + (unsigned)col0) * 2u;
#pragma unroll
                for (int bj = 0; bj < 2; ++bj) { f32x4 v0 = acc[ai][bj][m][0], v1 = acc[ai][bj][m][1];
                    if (act == 1) {
#pragma unroll
                        for (int j = 0; j < 4; ++j) { v0[j] = v0[j] * sigmoid_f(v0[j]); v1[j] = v1[j] * sigmoid_f(v1[j]); } }
                    else if (act == 2) {
#pragma unroll
                        for (int j = 0; j < 4; ++j) { v0[j] = sigmoid_f(v0[j]); v1[j] = sigmoid_f(v1[j]); } }
                    u32x4 w; w.x = cvt_pk_bf16(v0[0], v0[1]); w.y = cvt_pk_bf16(v0[2], v0[3]); w.z = cvt_pk_bf16(v1[0], v1[1]); w.w = cvt_pk_bf16(v1[2], v1[3]);
                    __builtin_amdgcn_raw_buffer_store_b128(w, rsrc, rowoff + (unsigned)(bj * HALF * 2), 0, 16  ); } }
    }
};
struct EpiY {
    static constexpr bool PERM = true, AFTER_DRAIN = false;
    bf16_t* O; int ldc;
    __device__ __forceinline__ void operator()(const f32x4 (&acc)[2][2][4][2], const Unit& u, int wr, int wc, int fr, int fq) const {
        bf16_t* base = O + (size_t)(u.pm * BM) * ldc + u.pn * BM;
        const int row0 = wr * 64 + fr, col0 = wc * 32 + 8 * fq;
#pragma unroll
        for (int ai = 0; ai < 2; ++ai)
#pragma unroll
            for (int m = 0; m < 4; ++m) { bf16_t* rowp = base + (size_t)(row0 + ai * HALF + m * 16) * ldc + col0;
#pragma unroll
                for (int bj = 0; bj < 2; ++bj) { const f32x4 v0 = acc[ai][bj][m][0], v1 = acc[ai][bj][m][1];
                    u32x4 w; w.x = cvt_pk_bf16(v0[0], v0[1]); w.y = cvt_pk_bf16(v0[2], v0[3]); w.z = cvt_pk_bf16(v1[0], v1[1]); w.w = cvt_pk_bf16(v1[2], v1[3]);
                    *(u32x4*)(rowp + bj * HALF) = w; } }
    }
};
struct InProjOrder {
    int G, c; unsigned* early;
    __device__ __forceinline__ bool next(int i, Unit& u) const {
        const int L = i * G + c; if (L >= 1424) return false;
        u.tag = (L >= 1280) ? 2 : ((L + G >= 1280) ? 1 : 0);
        if (L < 16) { u.pm = 32 + (L >> 3); u.pn = 44 + (L & 7); return true; }
        const int Lp = L - 16, xcd = Lp % NXCD, off = Lp / NXCD;
        const int ci = off >> 3, row = off & 7;
        u.pm = 8 * (xcd >> 1) + row;
        u.pn = (xcd & 1) ? (ci == 0 ? 19 : (ci < 9 ? 19 + ci : (ci < 17 ? 27 + ci : (ci < 20 ? 16 + ci : 10 + ci)))) : (ci < 19 ? ci : (ci == 19 ? 32 : 8 + ci));
        return true;
    }
    __device__ __forceinline__ void a_ready(const Unit&) const {}
    __device__ __forceinline__ void done(const Unit& u) const {
        if (u.tag) {
            asm volatile("s_waitcnt vmcnt(0)" ::: "memory");
            if ((threadIdx.x & 63) == 0) __hip_atomic_fetch_add(u.tag == 1 ? early : early + 64, 1u, __ATOMIC_RELAXED, __HIP_MEMORY_SCOPE_AGENT);
        }
    }
};
template <class Epi, class Sched, bool ALIGN_EPI = false, bool SP2 = false>
__device__ __forceinline__ void gemm_phase(PG8_LAS unsigned char* lds, const Gemm g, const Sched& S, const Epi& E) {
    const int tid = threadIdx.x, wid = __builtin_amdgcn_readfirstlane(tid >> 6), lane = tid & 63, wr = wid >> 2, wc = wid & 3, fr = lane & 15, fq = lane >> 4;
    const int K = g.K, nt = K / BK;
    unsigned voffA[2], voffB[2];
#pragma unroll
    for (int i = 0; i < 2; ++i) { int R, C; stage_rc(tid * 16 + i * 8192, R, C); const int Rb = Epi::PERM ? ((R & ~31) + perm32(R & 31)) : R;
        voffA[i] = (unsigned)(R * K + C) * 2u; voffB[i] = (unsigned)(Rb * K + C) * 2u; }
    const size_t kstep = (size_t)(BK * 2);
    const size_t hstep = (size_t)HALF * K * 2;
    const size_t tstep = 2 * hstep;
    const unsigned ldsw = (unsigned)wid * 1024u;
    const int aoff = lds_byte(wr * 64 + fr, fq * 8), boff = lds_byte(wc * 32 + fr, fq * 8);
#define PG8_SA(b, h) (((b) * 2 + (h)) * HTB)
#define PG8_SB(b, h) ((4 + (b) * 2 + (h)) * HTB)
#define PG8_STAGE(bufoff, gbase, voff) do { _Pragma("unroll") for (int _i = 0; _i < 2; ++_i) \
        __builtin_amdgcn_global_load_lds((const unsigned*)((const char*)(gbase) + (voff)[_i]), (PG8_LAS unsigned*)(lds + (bufoff) + ldsw + _i * 8192), 16, 0, 0); } while (0)
#define PG8_LDA(dst, b, h) do { _Pragma("unroll") for (int m = 0; m < 4; ++m) _Pragma("unroll") for (int k = 0; k < 2; ++k) dst[m][k] = *(const PG8_LAS bf16x8*)(lds + PG8_SA(b, h) + aoff + m * 2048 + k * 1024); } while (0)
#define PG8_LDB(dst, b, h) do { _Pragma("unroll") for (int n = 0; n < 2; ++n) _Pragma("unroll") for (int k = 0; k < 2; ++k) dst[n][k] = *(const PG8_LAS bf16x8*)(lds + PG8_SB(b, h) + boff + n * 2048 + k * 1024); } while (0)
#define PG8_MMA(ai, bj, At, Bt) do { __builtin_amdgcn_s_setprio(1); _Pragma("unroll") for (int m = 0; m < 4; ++m) _Pragma("unroll") for (int n = 0; n < 2; ++n) _Pragma("unroll") for (int k = 0; k < 2; ++k) \
        acc[ai][bj][m][n] = __builtin_amdgcn_mfma_f32_16x16x32_bf16(Bt[n][k], At[m][k], acc[ai][bj][m][n], 0, 0, 0); __builtin_amdgcn_s_setprio(0); } while (0)
#define PG8_WAIT_V(n) asm volatile("s_waitcnt vmcnt(" #n ")" ::: "memory")
#define PG8_WAIT_L(n) asm volatile("s_waitcnt lgkmcnt(" #n ")" ::: "memory")
#define PG8_BAR __builtin_amdgcn_s_barrier()
#define PG8_SCHED __builtin_amdgcn_sched_barrier(0)
    Unit cur, nxt; int ui = 0;
    if (!S.next(0, cur)) return;
    f32x4 acc[2][2][4][2];
#pragma unroll
    for (int a = 0; a < 2; ++a)
#pragma unroll
        for (int b = 0; b < 2; ++b)
#pragma unroll
            for (int m = 0; m < 4; ++m)
#pragma unroll
                for (int n = 0; n < 2; ++n) acc[a][b][m][n] = (f32x4){0.f, 0.f, 0.f, 0.f};
    bf16x8 At[4][2], B0[2][2], B1[2][2];
    const char* cA = (const char*)g.A + (size_t)cur.pm * tstep; const char* cB = (const char*)g.Bt + (size_t)cur.pn * tstep;
    S.a_ready(cur);
    if constexpr (SP2) {
        PG8_STAGE(PG8_SB(0, 0), cB, voffB); PG8_STAGE(PG8_SB(0, 1), cB + hstep, voffB); PG8_STAGE(PG8_SA(0, 0), cA, voffA); PG8_STAGE(PG8_SA(0, 1), cA + hstep, voffA);
        if (wr == 1) PG8_BAR;
        PG8_WAIT_V(2); PG8_BAR;
        PG8_STAGE(PG8_SB(1, 0), cB + kstep, voffB); PG8_STAGE(PG8_SA(1, 0), cA + kstep, voffA); PG8_STAGE(PG8_SB(1, 1), cB + hstep + kstep, voffB);
        PG8_WAIT_V(6); PG8_BAR;
    } else {
        PG8_STAGE(PG8_SB(0, 0), cB, voffB); PG8_STAGE(PG8_SA(0, 0), cA, voffA); PG8_STAGE(PG8_SB(0, 1), cB + hstep, voffB); PG8_STAGE(PG8_SA(0, 1), cA + hstep, voffA);
        if (wr == 1) PG8_BAR;
        PG8_WAIT_V(4); PG8_BAR;
        PG8_STAGE(PG8_SB(1, 0), cB + kstep, voffB); PG8_STAGE(PG8_SA(1, 0), cA + kstep, voffA); PG8_STAGE(PG8_SB(1, 1), cB + hstep + kstep, voffB);
        PG8_WAIT_V(6); PG8_BAR;
    }
    for (;;) {
        const bool has_next = S.next(ui + 1, nxt);
        const char* nA = has_next ? (const char*)g.A + (size_t)nxt.pm * tstep : cA; const char* nB = has_next ? (const char*)g.Bt + (size_t)nxt.pn * tstep : cB;
        for (int t = 0; t < nt; t += 2) {
            const bool last = (t == nt - 2);
            const char* a1 = cA + (size_t)(t + 1) * kstep;
            const char* a2 = last ? nA : cA + (size_t)(t + 2) * kstep; const char* b2 = last ? nB : cB + (size_t)(t + 2) * kstep;
            const char* a3 = a2 + kstep; const char* b3 = b2 + kstep;
            if (last && has_next) S.a_ready(nxt);
            if constexpr (SP2) {
            PG8_LDB(B0, 0, 0); PG8_LDB(B1, 0, 1); PG8_SCHED; PG8_LDA(At, 0, 0); PG8_STAGE(PG8_SA(1, 1), a1 + hstep, voffA);
            PG8_WAIT_V(8); PG8_WAIT_L(0); PG8_BAR; PG8_MMA(0, 0, At, B0); PG8_MMA(0, 1, At, B1); PG8_BAR; PG8_SCHED;
            PG8_LDA(At, 0, 1); PG8_STAGE(PG8_SB(0, 0), b2, voffB); PG8_STAGE(PG8_SB(0, 1), b2 + hstep, voffB); PG8_STAGE(PG8_SA(0, 0), a2, voffA);
            PG8_WAIT_V(8); PG8_WAIT_L(0); PG8_BAR; PG8_MMA(1, 0, At, B0); PG8_MMA(1, 1, At, B1); PG8_BAR; PG8_SCHED;
            PG8_LDB(B0, 1, 0); PG8_LDB(B1, 1, 1); PG8_SCHED; PG8_LDA(At, 1, 0); PG8_STAGE(PG8_SA(0, 1), a2 + hstep, voffA);
            PG8_WAIT_V(8); PG8_WAIT_L(0); PG8_BAR; PG8_MMA(0, 0, At, B0); PG8_MMA(0, 1, At, B1); PG8_BAR; PG8_SCHED;
            PG8_LDA(At, 1, 1); PG8_STAGE(PG8_SB(1, 0), b3, voffB); PG8_STAGE(PG8_SB(1, 1), b3 + hstep, voffB); PG8_STAGE(PG8_SA(1, 0), a3, voffA);
            PG8_WAIT_V(8); PG8_WAIT_L(0); PG8_BAR; PG8_MMA(1, 0, At, B0); PG8_MMA(1, 1, At, B1); PG8_BAR; PG8_SCHED;
            } else {
            PG8_LDB(B0, 0, 0); PG8_SCHED; PG8_LDA(At, 0, 0); PG8_STAGE(PG8_SA(1, 1), a1 + hstep, voffA);
            PG8_WAIT_L(8); PG8_BAR; PG8_WAIT_L(0); PG8_MMA(0, 0, At, B0); PG8_BAR; PG8_SCHED;
            PG8_LDB(B1, 0, 1); PG8_STAGE(PG8_SB(0, 0), b2, voffB);
            PG8_BAR; PG8_WAIT_L(0); PG8_MMA(0, 1, At, B1); PG8_BAR;
            PG8_LDA(At, 0, 1); PG8_STAGE(PG8_SA(0, 0), a2, voffA);
            PG8_BAR; PG8_WAIT_L(0); PG8_MMA(1, 0, At, B0); PG8_BAR; PG8_SCHED;
            PG8_STAGE(PG8_SB(0, 1), b2 + hstep, voffB);
            PG8_WAIT_V(6); PG8_BAR; PG8_MMA(1, 1, At, B1); PG8_BAR;
            PG8_LDB(B0, 1, 0); PG8_SCHED; PG8_LDA(At, 1, 0); PG8_STAGE(PG8_SA(0, 1), a2 + hstep, voffA);
            PG8_WAIT_L(8); PG8_BAR; PG8_WAIT_L(0); PG8_MMA(0, 0, At, B0); PG8_BAR; PG8_SCHED;
            PG8_LDB(B1, 1, 1); PG8_STAGE(PG8_SB(1, 0), b3, voffB);
            PG8_BAR; PG8_WAIT_L(0); PG8_MMA(0, 1, At, B1); PG8_BAR;
            PG8_LDA(At, 1, 1); PG8_STAGE(PG8_SA(1, 0), a3, voffA);
            PG8_BAR; PG8_WAIT_L(0); PG8_MMA(1, 0, At, B0); PG8_BAR; PG8_SCHED;
            PG8_STAGE(PG8_SB(1, 1), b3 + hstep, voffB);
            PG8_WAIT_V(6); PG8_BAR; PG8_MMA(1, 1, At, B1); PG8_BAR;
            }
        }
        if constexpr (ALIGN_EPI) { if (wr == 0) PG8_BAR; }
        if constexpr (!Epi::AFTER_DRAIN) { E(acc, cur, wr, wc, fr, fq); S.done(cur); }
        if (!has_next) break;
#pragma unroll
        for (int a = 0; a < 2; ++a)
#pragma unroll
            for (int b = 0; b < 2; ++b)
#pragma unroll
                for (int m = 0; m < 4; ++m)
#pragma unroll
                    for (int n = 0; n < 2; ++n) acc[a][b][m][n] = (f32x4){0.f, 0.f, 0.f, 0.f};
        cur = nxt; cA = nA; cB = nB; ++ui;
        if constexpr (ALIGN_EPI) { if (wr == 1) PG8_BAR; }
    }
    PG8_WAIT_V(0);
    if constexpr (!ALIGN_EPI) { if (wr == 0) PG8_BAR; }
    PG8_BAR;
    if constexpr (Epi::AFTER_DRAIN) { E.fused(acc, cur, wr, wc, fr, fq, lds, wid, lane); S.done(cur); }
#undef PG8_SA
#undef PG8_SB
#undef PG8_STAGE
#undef PG8_LDA
#undef PG8_LDB
#undef PG8_MMA
#undef PG8_WAIT_V
#undef PG8_WAIT_L
#undef PG8_BAR
#undef PG8_SCHED
}
}
#define GAS __attribute__((address_space(1)))
#define LAS __attribute__((address_space(3)))
typedef unsigned short bf16;
typedef unsigned v4u __attribute__((ext_vector_type(4)));
typedef float f32x4 __attribute__((ext_vector_type(4)));
typedef short bf16x8 __attribute__((ext_vector_type(8)));
typedef GAS unsigned gu32;
typedef GAS unsigned long long gu64;
#define RLX_AGENT __ATOMIC_RELAXED, __HIP_MEMORY_SCOPE_AGENT
#define LDS_WAIT() asm volatile("s_waitcnt lgkmcnt(0)" ::: "memory")
#define VM_WAIT() asm volatile("s_waitcnt vmcnt(0)" ::: "memory")
__device__ __forceinline__ unsigned long long rt() { return __builtin_amdgcn_s_memrealtime(); }
__device__ __forceinline__ unsigned f2bf(float f) { unsigned u = __builtin_bit_cast(unsigned, f); return (u + 0x7fffu + ((u >> 16) & 1u)) >> 16; }
__device__ __forceinline__ unsigned pk2(float lo, float hi) { return f2bf(lo) | (f2bf(hi) << 16); }

#define XB_TMO      128
#define XB_XCNT(j)  (256  + 64 * (j))
#define XB_XSUB(j)  (1280 + 64 * (j))
#define XB_XGEN(j)  (2304 + 64 * (j))
#define XB_TOP      3328
#define XB_TOPGEN   3392
#define XCD_BAR_WORDS 3456
#define XB_SPIN_CAP (1u << 18)

__device__ __forceinline__ unsigned xb_ld(unsigned* p)              { return __hip_atomic_load(p, __ATOMIC_RELAXED, __HIP_MEMORY_SCOPE_AGENT); }
__device__ __forceinline__ unsigned xb_add(unsigned* p, unsigned v) { return __hip_atomic_fetch_add(p, v, __ATOMIC_RELAXED, __HIP_MEMORY_SCOPE_AGENT); }
__device__ __forceinline__ unsigned xb_xcc_id() { return (unsigned)__builtin_amdgcn_s_getreg((3 << 11) | 20) & 0xFu; }
#define XB_SPIN(cond, bar) do { unsigned _sp = 0; while (cond) { __builtin_amdgcn_s_sleep(1); \
    if ((++_sp & 255u) == 0u) { if (xb_ld(&(bar)[XB_TMO])) break; if (_sp > XB_SPIN_CAP) { atomicAdd(&(bar)[XB_TMO], 1u); break; } } } } while (0)

struct XcdBarrier {
    unsigned* bar; unsigned x;
    volatile LAS unsigned* st;
};

__device__ __forceinline__ XcdBarrier xcd_barrier_post(unsigned* bar, volatile LAS unsigned* st) {
    XcdBarrier b; b.bar = bar; b.x = xb_xcc_id(); b.st = st;
    if (threadIdx.x == 0) (void)xb_add(&bar[XB_XCNT(b.x)], 1u);
    return b;
}
__device__ __forceinline__ void xcd_barrier_complete(unsigned* bar, unsigned x, unsigned& nloc, unsigned& nx) {
    const unsigned G = gridDim.x * gridDim.y * gridDim.z;
    unsigned sum, cnt, mine, sp = 0u;
    for (;;) {
        sum = 0u; cnt = 0u; mine = 0u;
#pragma unroll
        for (unsigned j = 0; j < 16; ++j) { const unsigned c = xb_ld(&bar[XB_XCNT(j)]); sum += c; cnt += (c > 0u) ? 1u : 0u; mine = (j == x) ? c : mine; }
        if (sum == G) break;
        __builtin_amdgcn_s_sleep(1);
        if ((++sp & 255u) == 0u) { if (xb_ld(&bar[XB_TMO])) break; if (sp > XB_SPIN_CAP) { atomicAdd(&bar[XB_TMO], 1u); break; } }
    }
    nloc = mine > 0u ? mine : 1u; nx = cnt > 0u ? cnt : 1u;
}

__device__ __forceinline__ void xcd_barrier(const XcdBarrier& b) {
    asm volatile("s_waitcnt vmcnt(0)" ::: "memory");
    __syncthreads();
    if (threadIdx.x == 0) {
        unsigned* bar = b.bar;
        __builtin_amdgcn_s_waitcnt(0);
        unsigned nloc = b.st[0], nx = b.st[1];
        if (nloc == 0u) { xcd_barrier_complete(bar, b.x, nloc, nx); b.st[0] = nloc; b.st[1] = nx; }
        const unsigned old = xb_add(&bar[XB_XSUB(b.x)], 1u);
        const unsigned gen = old / nloc;
        if (old + 1u == (gen + 1u) * nloc) {
            __builtin_amdgcn_fence(__ATOMIC_RELEASE, "agent");
            asm volatile("s_waitcnt vmcnt(0)" ::: "memory");
            const unsigned og = xb_add(&bar[XB_TOP], 1u);
            const unsigned tg = og / nx;
            if (og + 1u == (tg + 1u) * nx) xb_add(&bar[XB_TOPGEN], 1u);
            else XB_SPIN(xb_ld(&bar[XB_TOPGEN]) == tg, bar);
            __builtin_amdgcn_fence(__ATOMIC_ACQUIRE, "agent");
            xb_add(&bar[XB_XGEN(b.x)], 1u);
            asm volatile("s_waitcnt vmcnt(0)" ::: "memory");
        } else {
            XB_SPIN(xb_ld(&bar[XB_XGEN(b.x)]) == gen, bar);
            __builtin_amdgcn_fence(__ATOMIC_ACQUIRE, "agent");
            asm volatile("s_waitcnt vmcnt(0)" ::: "memory");
        }
    }
    __syncthreads();
}
constexpr int NWAVES = 8;
constexpr int DM = 4096, SEQ = 4096, MROWS = 8192, MEMROWS = 512;
constexpr int INW = 11272;
constexpr int NPROJ = 11264;
constexpr int C_AQ = 0, C_AK = 2048, C_AV = 2560, C_AZ = 3072, C_MQ = 5120, C_MK = 5632, C_MV = 6144, C_MO = 7168, C_MZ = 8192, C_CQ = 9216, C_CZ = 10240;
constexpr float LN_EPS = 1e-5f, HEAD_NORM_EPS = 1e-6f;
constexpr float DEEPNORM_ALPHA = 1.189207115002721f;

constexpr size_t MiB = 1u << 20;
constexpr size_t WS_CTL = 0, CTL_ZERO_BYTES = 32768;
constexpr size_t WS_ACAT = 2 * MiB;
constexpr size_t WS_BTCAT = 70 * MiB;
constexpr size_t WS_WOT = 174 * MiB;
constexpr size_t WS_PROJ = 206 * MiB;
constexpr size_t WS_MKV = 382 * MiB;
constexpr size_t WS_GATES = 384 * MiB;
constexpr size_t WS_MQK = 385 * MiB;
constexpr size_t WS_CLOC = 401 * MiB;
constexpr size_t WS_CPREV = 435 * MiB;
constexpr size_t WS_SMALL = 452 * MiB;
constexpr size_t WS_MIX = 453 * MiB;
constexpr size_t WS_Y = 517 * MiB;
constexpr size_t WS_END = 581 * MiB;
constexpr int CW_BAR = 4096;
constexpr int CW_EARLY = 64, CW_LATE = 128  , CW_QHEAD = 192, CW_CLOCDONE = 256, CW_SCANDONE = 320;

constexpr int LDS_BYTES = 163840;
constexpr int MISC_OFF = LDS_BYTES - 256;

typedef unsigned v2u __attribute__((ext_vector_type(2)));
#define CAS __attribute__((address_space(4)))
struct Frame {
    LAS unsigned char* lds;
    volatile LAS unsigned* MISC;
    gu32* ctl;
    unsigned char* ws;
    const CAS unsigned char* kargs;
    int tid, lane, wave, G, vcu;
};
__device__ __forceinline__ const float* in_ptr(const Frame& F, int i) { const CAS unsigned char* p = F.kargs; asm volatile("" : "+s"(p)); return *(const float* const CAS*)(p + 8 * i); }
__device__ __forceinline__ float* out_ptr(const Frame& F) { const CAS unsigned char* p = F.kargs; asm volatile("" : "+s"(p)); return *(float* const CAS*)(p + 8 * 14); }
#define WSP(T, off) ((T*)(F.ws + (off)))
#ifdef PROBE_A
#define ISTAMP(k) do { __syncthreads(); if (F.tid == 0) F.MISC[20 + (k)] = (unsigned)__builtin_amdgcn_s_memrealtime(); __syncthreads(); } while (0)
#else
#define ISTAMP(k) do { } while (0)
#endif
__device__ __forceinline__ float bf2f(unsigned h) { return __builtin_bit_cast(float, h << 16); }
__device__ __forceinline__ float wave_sum(float v) {
#pragma unroll
    for (int o = 1; o < 64; o <<= 1) v += __shfl_xor(v, o);
    return v;
}
__device__ __forceinline__ float quad_max(float v) { v = fmaxf(v, __shfl_xor(v, 16)); v = fmaxf(v, __shfl_xor(v, 32)); return v; }
__device__ __forceinline__ float quad_sum(float v) { v += __shfl_xor(v, 16); v += __shfl_xor(v, 32); return v; }
__device__ __forceinline__ float row16_sum(float v) { v += __shfl_xor(v, 1); v += __shfl_xor(v, 2); v += __shfl_xor(v, 4); v += __shfl_xor(v, 8); return v; }
__device__ __forceinline__ float fast_exp(float v) { return __builtin_amdgcn_exp2f(1.4426950408889634f * v); }
__device__ __forceinline__ float sigmoidf_(float v) { return __builtin_amdgcn_rcpf(1.0f + fast_exp(-v)); }
__device__ __forceinline__ bf16x8 mk_frag(unsigned a, unsigned b, unsigned c, unsigned d) { v4u t; t.x = a; t.y = b; t.z = c; t.w = d; return __builtin_bit_cast(bf16x8, t); }
__device__ __forceinline__ bf16x8 ld_frag16(const LAS unsigned char* p) { return *(const LAS bf16x8*)p; }
__device__ __forceinline__ bf16x8 ld_frag8x2(const LAS unsigned char* p0, const LAS unsigned char* p1) {
    const v2u a = *(const LAS v2u*)p0, b = *(const LAS v2u*)p1; return mk_frag(a.x, a.y, b.x, b.y); }
#define MFMA16(a, b, c) __builtin_amdgcn_mfma_f32_16x16x32_bf16((a), (b), (c), 0, 0, 0)

__device__ __forceinline__ void stage_transposed(const bf16* src, size_t spitch, int nrows, int nch, LAS unsigned short* dst, int dpitch, const LAS float* rowscale, int tid) {
    for (int idx = tid; idx < nrows * nch; idx += NWAVES * 64) {
        const int row = idx & (nrows - 1), ch = idx / nrows;
        const v4u q = *(const GAS v4u*)(src + (size_t)row * spitch + ch * 8);
        unsigned e[8] = {q.x & 0xffffu, q.x >> 16, q.y & 0xffffu, q.y >> 16, q.z & 0xffffu, q.z >> 16, q.w & 0xffffu, q.w >> 16};
        LAS unsigned short* d = dst + (ch * 8) * dpitch + row;
        if (rowscale) { const float s = rowscale[row];
#pragma unroll
            for (int j = 0; j < 8; ++j) d[j * dpitch] = (unsigned short)f2bf(bf2f(e[j]) * s); }
        else {
#pragma unroll
            for (int j = 0; j < 8; ++j) d[j * dpitch] = (unsigned short)e[j]; }
    }
}

__device__ __forceinline__ void p0_transpose_item(const float* W, int ldw, bf16* WT, int row_off, LAS float* scr, int kb, int nb, int lane) {
    const int k0 = 64 * kb, n0 = 32 * nb;
    {   const int r8 = lane >> 3, cq = lane & 7;
        f32x4 t[8];
#pragma unroll
        for (int i = 0; i < 8; ++i) t[i] = *(const GAS f32x4*)(W + (size_t)(k0 + 8 * i + r8) * ldw + n0 + 4 * cq);
#pragma unroll
        for (int i = 0; i < 8; ++i) { LAS float* d = scr + (8 * i + r8) * 33 + 4 * cq; d[0] = t[i].x; d[1] = t[i].y; d[2] = t[i].z; d[3] = t[i].w; } }
    LDS_WAIT(); asm volatile("" ::: "memory");
    const int c = lane & 7;
#pragma unroll
    for (int j = 0; j < 4; ++j) { const int n = (lane >> 3) + 8 * j; const LAS float* s = scr + (8 * c) * 33 + n;
        v4u o; o.x = pk2(s[0 * 33], s[1 * 33]); o.y = pk2(s[2 * 33], s[3 * 33]); o.z = pk2(s[4 * 33], s[5 * 33]); o.w = pk2(s[6 * 33], s[7 * 33]);
        *(GAS v4u*)(WT + (size_t)(row_off + n0 + n) * DM + k0 + 8 * c) = o; }
    LDS_WAIT(); asm volatile("" ::: "memory");
}
__device__ __forceinline__ void wout_item(Frame& F, int item) {
    const float* w_out = in_ptr(F, 11); bf16* WOT = WSP(bf16, WS_WOT);
    LAS float* scr = (LAS float*)(F.lds + F.wave * 16384);
    for (int j = 0; j < 8; ++j) { const int r = item * 64 + j * 8 + F.wave; p0_transpose_item(w_out, DM, WOT, 0, scr, r / 128, r % 128, F.lane); }
    __syncthreads();
}
typedef __bf16 bf16x2_t __attribute__((ext_vector_type(2)));
__device__ __forceinline__ float dot2_bf16(unsigned w, unsigned x, float acc) { return __builtin_amdgcn_fdot2_f32_bf16(__builtin_bit_cast(bf16x2_t, w), __builtin_bit_cast(bf16x2_t, x), acc, false); }
__device__ __forceinline__ void p0_prologue(Frame& F) {
    const float* x = in_ptr(F, 0); const float* mem = in_ptr(F, 1); const float* w_in = in_ptr(F, 2); const float* b_i = in_ptr(F, 5); const float* b_f = in_ptr(F, 6); const float* w_mem_kv = in_ptr(F, 10); bf16* ACAT = WSP(bf16, WS_ACAT); bf16* BTCAT = WSP(bf16, WS_BTCAT); float* GATES = WSP(float, WS_GATES);
    const int gw = F.vcu * NWAVES + F.wave, NGW = F.G * NWAVES;
    LAS float* scr = (LAS float*)(F.lds + F.wave * 8448);
    LAS unsigned short* GW = (LAS unsigned short*)(F.lds + 67584);
    {   f32x4 ga[8], gb[8];
#pragma unroll
        for (int i = 0; i < 8; ++i) { const GAS f32x4* p = (const GAS f32x4*)(w_in + (size_t)(F.tid + 512 * i) * INW + 7168); ga[i] = p[0]; gb[i] = p[1]; }
#pragma unroll
        for (int i = 0; i < 8; ++i) { const int k = F.tid + 512 * i;
            GW[0 * DM + k] = (unsigned short)f2bf(ga[i].x); GW[1 * DM + k] = (unsigned short)f2bf(ga[i].y); GW[2 * DM + k] = (unsigned short)f2bf(ga[i].z); GW[3 * DM + k] = (unsigned short)f2bf(ga[i].w);
            GW[4 * DM + k] = (unsigned short)f2bf(gb[i].x); GW[5 * DM + k] = (unsigned short)f2bf(gb[i].y); GW[6 * DM + k] = (unsigned short)f2bf(gb[i].z); GW[7 * DM + k] = (unsigned short)f2bf(gb[i].w); } }
    __syncthreads();
    const float gate_bias = (F.lane < 4) ? b_i[F.lane] : ((F.lane < 8) ? b_f[F.lane - 4] : 0.f);
    constexpr int I0 = 64 * 224, I1 = 64 * 128, I2 = 64 * 64, NITEMS = I0 + I1 + I2;
    int it = gw;
#define P0_ITEMS(n) do { _Pragma("unroll 1") for (int c_ = 0; c_ < (n) && it < NITEMS; ++c_, it += NGW) { int r = it; \
        if (r < I0) p0_transpose_item(w_in, INW, BTCAT, 0, scr, r / 224, r % 224, F.lane); \
        else if ((r -= I0) < I1) p0_transpose_item(w_in + 7176, INW, BTCAT, 7168, scr, r / 128, r % 128, F.lane); \
        else { r -= I1; p0_transpose_item(w_mem_kv, 2048, BTCAT, 11264, scr, r / 64, r % 64, F.lane); } } } while (0)
#pragma unroll 1
    for (int m = gw; m < MROWS + MEMROWS; m += NGW) {
        const bool isx = m < MROWS;
        const GAS f32x4* xr = (const GAS f32x4*)((isx ? x : mem) + (size_t)(isx ? m : m - MROWS) * DM) + F.lane;
        f32x4 v[16];
#pragma unroll
        for (int j = 0; j < 16; ++j) v[j] = xr[64 * j];
        P0_ITEMS(3);
        GAS v2u* o8 = (GAS v2u*)(ACAT + (size_t)m * DM) + F.lane;
        v2u xp[16];
#pragma unroll
        for (int j = 0; j < 16; ++j) { xp[j].x = pk2(v[j].x, v[j].y); xp[j].y = pk2(v[j].z, v[j].w); o8[64 * j] = xp[j]; }
        if (isx) {
            float res = 0.f;
#pragma unroll 1
            for (int g = 0; g < 8; ++g) { float a0 = 0.f, a1 = 0.f;
#pragma unroll
                for (int j = 0; j < 16; ++j) { const v2u w = *(const LAS v2u*)(GW + g * DM + 256 * j + 4 * F.lane); a0 = dot2_bf16(w.x, xp[j].x, a0); a1 = dot2_bf16(w.y, xp[j].y, a1); }
                a0 = wave_sum(a0 + a1); res = (F.lane == g) ? a0 : res; }
            if (F.lane < 8) GATES[(size_t)m * 8 + F.lane] = res + gate_bias;
        }
    }
    P0_ITEMS(1 << 30);
#undef P0_ITEMS
}

__device__ __forceinline__ float log_sigmoid_f(float v) { return fminf(v, 0.f) - log1pf(expf(-fabsf(v))); }
template <int OP> __device__ __forceinline__ void wave_scan128(const LAS float* in, LAS float* out, int lane) {
    const float e0 = in[2 * lane], e1 = in[2 * lane + 1];
    float s = OP ? fmaxf(e0, e1) : (e0 + e1);
#pragma unroll
    for (int o = 1; o < 64; o <<= 1) { const float t = __shfl_up(s, o); if (lane >= o) s = OP ? fmaxf(s, t) : (s + t); }
    float ex = __shfl_up(s, 1);
    if (OP) { const float a = (lane == 0) ? e0 : fmaxf(ex, e0); out[2 * lane] = a; out[2 * lane + 1] = fmaxf(a, e1); }
    else { const float a = (lane == 0) ? e0 : (ex + e0); out[2 * lane] = a; out[2 * lane + 1] = a + e1; }
}

typedef short s16x4 __attribute__((ext_vector_type(4)));
__device__ __forceinline__ s16x4 ds_tr(const LAS unsigned char* p) { return __builtin_bit_cast(s16x4, __builtin_amdgcn_ds_read_tr16_b64_v4i16((LAS s16x4*)p)); }
__device__ __forceinline__ bf16x8 tr_frag(const LAS unsigned char* p0, const LAS unsigned char* p1) { const s16x4 a = ds_tr(p0), b = ds_tr(p1); return __builtin_shufflevector(a, b, 0, 1, 2, 3, 4, 5, 6, 7); }
__device__ __forceinline__ v4u ldg16(const bf16* p) { return *(const GAS v4u*)p; }
__device__ __forceinline__ void stg16(bf16* p, v4u v) { *(GAS v4u*)p = v; }
__device__ __forceinline__ void ws_store16_sc1(const Frame& F, size_t off, v4u v) {
    const __amdgpu_buffer_rsrc_t rsrc = __builtin_amdgcn_make_buffer_rsrc(F.ws, 0, (unsigned)WS_END, 0x00020000);
    __builtin_amdgcn_raw_buffer_store_b128(v, rsrc, (unsigned)off, 0, 16); }
__device__ __forceinline__ v4u zero4() { v4u z; z.x = 0u; z.y = 0u; z.z = 0u; z.w = 0u; return z; }
__device__ __forceinline__ v4u gate_pack(f32x4 a, f32x4 b, float s, v4u z) {
    v4u o;
    o.x = pg8::cvt_pk_bf16(a[0] * s * bf2f(z.x & 0xffffu), a[1] * s * bf2f(z.x >> 16)); o.y = pg8::cvt_pk_bf16(a[2] * s * bf2f(z.y & 0xffffu), a[3] * s * bf2f(z.y >> 16));
    o.z = pg8::cvt_pk_bf16(b[0] * s * bf2f(z.z & 0xffffu), b[1] * s * bf2f(z.z >> 16)); o.w = pg8::cvt_pk_bf16(b[2] * s * bf2f(z.w & 0xffffu), b[3] * s * bf2f(z.w >> 16));
    return o;
}

__device__ __forceinline__ void scan_item(Frame& F, int sl) {
    float* CLOC = WSP(float, WS_CLOC); float* CST = WSP(float, WS_SMALL); float* MPREV = WSP(float, WS_SMALL + 4096);
    const int gt = sl * (NWAVES * 64) + F.tid;
    constexpr int OCT = 257 * 16;
    if (gt < 8 * OCT) {
        const int bh = gt / OCT, off = (gt % OCT) * 8;
        float m = 0.f; f32x4 c0 = {0.f, 0.f, 0.f, 0.f}, c1 = {0.f, 0.f, 0.f, 0.f};
#pragma unroll 8
        for (int c = 0; c < 32; ++c) {
            const int item = bh * 32 + c;
            const float gl = CST[item * 2], ml = CST[item * 2 + 1];
            const GAS f32x4* cp = (const GAS f32x4*)(CLOC + (size_t)item * (257 * 128) + off);
            const f32x4 cl0 = cp[0], cl1 = cp[1];
            v4u o; o.x = pk2(c0[0], c0[1]); o.y = pk2(c0[2], c0[3]); o.z = pk2(c1[0], c1[1]); o.w = pk2(c1[2], c1[3]);
            ws_store16_sc1(F, WS_CPREV + ((size_t)item * (257 * 128) + off) * 2, o);
            if (off == 0) __hip_atomic_store(MPREV + item, m, RLX_AGENT);
            const float mn = fmaxf(gl + m, ml), sp = expf(gl + m - mn), sl2 = expf(ml - mn);
            c0 = c0 * sp + cl0 * sl2; c1 = c1 * sp + cl1 * sl2; m = mn;
        }
    }
    asm volatile("s_waitcnt vmcnt(0)" ::: "memory");
    __syncthreads();
    if (F.tid == 0) __hip_atomic_fetch_add(F.ctl + CW_SCANDONE, 1u, RLX_AGENT);
}

__device__ __forceinline__ void swa_item4(Frame& F, int item) {
    int tid = F.tid; asm volatile("" : "+v"(tid)); const int lane = tid & 63;
    const float* rel_bias = in_ptr(F, 8); const float* sinks = in_ptr(F, 9); bf16* PROJ = WSP(bf16, WS_PROJ); bf16* MIX = WSP(bf16, WS_MIX);
    const int b = item >> 7, n = (item >> 2) & 31, kv = item & 3;
    const int row0 = b * SEQ + n * 128;
    LAS unsigned char* Ks = F.lds;
    LAS unsigned char* Vs = F.lds + 69632;
    LAS float* BT = (LAS float*)(F.lds + 143360);
    const int g = F.wave >> 1, head = kv * 4 + g, l15 = lane & 15, quad = lane >> 4, tq = (lane & 15) >> 2, tp = lane & 3;
    const int qw = (F.wave & 1) * 64;
    bf16x8 qf[2][2][4];
#pragma unroll
    for (int ds = 0; ds < 2; ++ds)
#pragma unroll
        for (int qt = 0; qt < 2; ++qt) { const bf16* qp = PROJ + (size_t)(row0 + qw + 32 * ds + 16 * qt + l15) * NPROJ + C_AQ + head * 128 + 8 * quad;
#pragma unroll
            for (int ks = 0; ks < 4; ++ks) qf[ds][qt][ks] = __builtin_bit_cast(bf16x8, ldg16(qp + 32 * ks)); }
    {   const int gg = tid >> 7, dist = tid & 127; int bucket = dist;
        if (dist >= 16) { const float ratio = (float)dist / 16.0f; const int lg = 16 + (int)(logf(ratio) / logf(8.0f) * 16.0f); bucket = lg < 31 ? lg : 31; }
        BT[gg * 128 + dist] = rel_bias[bucket * 16 + kv * 4 + gg] * 1.4426950408889634f; }
    {   v4u kq[8], vq[8];
#pragma unroll
        for (int it = 0; it < 8; ++it) { const int idx = tid + 512 * it, key = idx >> 4, ch = idx & 15; const bool valid = (n > 0) || (key >= 128);
            kq[it] = zero4(); vq[it] = zero4();
            if (valid) { const bf16* src = PROJ + (size_t)(row0 - 128 + key) * NPROJ + kv * 128 + ch * 8; kq[it] = ldg16(src + C_AK); vq[it] = ldg16(src + C_AV); } }
#pragma unroll
        for (int it = 0; it < 8; ++it) { const int idx = tid + 512 * it, key = idx >> 4, ch = idx & 15;
            *(LAS v4u*)(Ks + key * 272 + ch * 16) = kq[it]; *(LAS v4u*)(Vs + key * 288 + ch * 16) = vq[it]; } }
    __syncthreads();
    ISTAMP(26);
    const float sink = sinks[head];
    const float scale = 0.08838834764831845f;
#pragma unroll
    for (int ds = 0; ds < 2; ++ds) {
        const int q0 = qw + 32 * ds, kbase = q0;
        v4u zz[2][4];
#pragma unroll
        for (int qt = 0; qt < 2; ++qt) { const bf16* zp = PROJ + (size_t)(row0 + q0 + 16 * qt + l15) * NPROJ + C_AZ + head * 128 + 8 * quad;
#pragma unroll
            for (int P2 = 0; P2 < 4; ++P2) zz[qt][P2] = ldg16(zp + 32 * P2); }
        f32x4 st[2][10];
#pragma unroll
        for (int kt = 0; kt < 10; ++kt) { f32x4 a0 = {0.f, 0.f, 0.f, 0.f}, a1 = {0.f, 0.f, 0.f, 0.f}; const LAS unsigned char* kp = Ks + (kbase + 16 * kt + l15) * 272 + 16 * quad;
#pragma unroll
            for (int ks = 0; ks < 4; ++ks) { const bf16x8 kf = ld_frag16(kp + 64 * ks); a0 = MFMA16(kf, qf[ds][0][ks], a0); a1 = MFMA16(kf, qf[ds][1][ks], a1); }
            st[0][kt] = a0; st[1][kt] = a1; }
        if (ds == 0) ISTAMP(27);
        bf16x8 pb[2][5]; float inv[2];
        const float sc2 = scale * 1.4426950408889634f, sink2 = sink * 1.4426950408889634f;
        const LAS float* btl = BT + g * 128 + l15 - 4 * quad;
#pragma unroll
        for (int qt = 0; qt < 2; ++qt) {
            float mx = sink2;
            if (n > 0) {
#pragma unroll
                for (int kt = 0; kt < 10; ++kt) { const int delta = kt - qt;
                    if (delta < 0 || delta > 8) { st[qt][kt] = (f32x4){-INFINITY, -INFINITY, -INFINITY, -INFINITY}; continue; }
#pragma unroll
                    for (int r = 0; r < 4; ++r) { const int e = l15 - 4 * quad - r;
                        float sv = st[qt][kt][r] * sc2 + btl[128 - 16 * delta - r];
                        if (delta == 0) sv = (e < 0) ? sv : -INFINITY;
                        if (delta == 8) sv = (e >= 0) ? sv : -INFINITY;
                        st[qt][kt][r] = sv; mx = fmaxf(mx, sv); } }
            } else {
                const int qi = q0 + 16 * qt + l15;
#pragma unroll
                for (int kt = 0; kt < 10; ++kt)
#pragma unroll
                    for (int r = 0; r < 4; ++r) { const int si = kbase + 16 * kt + 4 * quad + r, dist = qi + 128 - si;
                        const bool ok = (dist >= 0) && (dist < 128) && (si >= 128);
                        const float sv = ok ? st[qt][kt][r] * sc2 + BT[g * 128 + (dist & 127)] : -INFINITY;
                        st[qt][kt][r] = sv; mx = fmaxf(mx, sv); }
            }
            mx = quad_max(mx);
            float sum = 0.f;
#pragma unroll
            for (int kt = 0; kt < 10; ++kt)
#pragma unroll
                for (int r = 0; r < 4; ++r) { const float p = __builtin_amdgcn_exp2f(st[qt][kt][r] - mx); st[qt][kt][r] = p; sum += p; }
            sum = quad_sum(sum) + __builtin_amdgcn_exp2f(sink2 - mx);
            inv[qt] = 1.0f / sum;
#pragma unroll
            for (int kp = 0; kp < 5; ++kp) { const f32x4 p0 = st[qt][2 * kp], p1 = st[qt][2 * kp + 1];
                pb[qt][kp] = mk_frag(pg8::cvt_pk_bf16(p0[0], p0[1]), pg8::cvt_pk_bf16(p0[2], p0[3]), pg8::cvt_pk_bf16(p1[0], p1[1]), pg8::cvt_pk_bf16(p1[2], p1[3])); }
        }
        if (ds == 0) ISTAMP(28);
        const LAS unsigned char* vb = Vs + (kbase + 4 * quad + tq) * 288 + 16 * tp;
#pragma unroll
        for (int P2 = 0; P2 < 4; ++P2) {
            f32x4 o00 = {0.f, 0.f, 0.f, 0.f}, o01 = o00, o10 = o00, o11 = o00;
#pragma unroll
            for (int kp = 0; kp < 5; ++kp) { const LAS unsigned char* va = vb + (32 * kp) * 288 + 64 * P2;
                const bf16x8 v0 = tr_frag(va, va + 16 * 288), v1 = tr_frag(va + 8, va + 16 * 288 + 8);
                o00 = MFMA16(v0, pb[0][kp], o00); o01 = MFMA16(v1, pb[0][kp], o01);
                o10 = MFMA16(v0, pb[1][kp], o10); o11 = MFMA16(v1, pb[1][kp], o11); }
            bf16* op = MIX + (size_t)(row0 + q0 + l15) * DM + head * 128 + 8 * quad + 32 * P2;
            stg16(op, gate_pack(o00, o01, inv[0], zz[0][P2]));
            stg16(op + (size_t)16 * DM, gate_pack(o10, o11, inv[1], zz[1][P2]));
        }
    }
    __syncthreads();
}

__device__ __forceinline__ void cross_item3(Frame& F, int item) {
    int tid = F.tid; asm volatile("" : "+v"(tid)); const int lane = tid & 63;
    bf16* PROJ = WSP(bf16, WS_PROJ); bf16* MKV = WSP(bf16, WS_MKV); bf16* MIX = WSP(bf16, WS_MIX);
    const int b = item >> 7, h = (item >> 5) & 3, qt = item & 31;
    const int l15 = lane & 15, quad = lane >> 4, tq = (lane & 15) >> 2, tp = lane & 3;
    const size_t grow = (size_t)b * SEQ + qt * 128 + F.wave * 16 + l15;
    const bf16* kvsrc = MKV + (size_t)(b * 256) * 2048 + h * 256;
    bf16x8 qf[8];
    { const bf16* qp = PROJ + grow * NPROJ + C_CQ + h * 256 + 8 * quad;
#pragma unroll
      for (int ks = 0; ks < 8; ++ks) qf[ks] = __builtin_bit_cast(bf16x8, ldg16(qp + 32 * ks)); }
    {   v4u t[16];
#pragma unroll
        for (int it = 0; it < 16; ++it) { const int idx = tid + 512 * it, m = idx >> 5, ch = idx & 31; t[it] = ldg16(kvsrc + (size_t)m * 2048 + ch * 8); }
#pragma unroll
        for (int it = 0; it < 16; ++it) { const int idx = tid + 512 * it, m = idx >> 5, ch = idx & 31; *(LAS v4u*)(F.lds + m * 528 + ch * 16) = t[it]; } }
    __syncthreads();
    v4u vt[16];
#pragma unroll
    for (int it = 0; it < 16; ++it) { const int idx = tid + 512 * it, m = idx >> 5, ch = idx & 31; vt[it] = ldg16(kvsrc + 1024 + (size_t)m * 2048 + ch * 8); }
    bf16x8 pb[8]; float inv;
    {
        f32x4 st[16];
#pragma unroll
        for (int kt = 0; kt < 16; ++kt) { f32x4 a = {0.f, 0.f, 0.f, 0.f}; const LAS unsigned char* kp = F.lds + (16 * kt + l15) * 528 + 16 * quad;
#pragma unroll
            for (int ks = 0; ks < 8; ++ks) a = MFMA16(ld_frag16(kp + 64 * ks), qf[ks], a);
            st[kt] = a; }
        float mx = -INFINITY;
#pragma unroll
        for (int kt = 0; kt < 16; ++kt)
#pragma unroll
            for (int r = 0; r < 4; ++r) { const float sc = st[kt][r] * 0.0625f; st[kt][r] = sc; mx = fmaxf(mx, sc); }
        mx = quad_max(mx);
        float sum = 0.f;
#pragma unroll
        for (int kt = 0; kt < 16; ++kt)
#pragma unroll
            for (int r = 0; r < 4; ++r) { const float p = fast_exp(st[kt][r] - mx); st[kt][r] = p; sum += p; }
        sum = quad_sum(sum);
        inv = 1.0f / sum;
#pragma unroll
        for (int kp = 0; kp < 8; ++kp) { const f32x4 p0 = st[2 * kp], p1 = st[2 * kp + 1];
            pb[kp] = mk_frag(pg8::cvt_pk_bf16(p0[0], p0[1]), pg8::cvt_pk_bf16(p0[2], p0[3]), pg8::cvt_pk_bf16(p1[0], p1[1]), pg8::cvt_pk_bf16(p1[2], p1[3])); }
    }
    __syncthreads();
#pragma unroll
    for (int it = 0; it < 16; ++it) { const int idx = tid + 512 * it, m = idx >> 5, ch = idx & 31; *(LAS v4u*)(F.lds + m * 544 + ch * 16) = vt[it]; }
    const bf16* zp = PROJ + grow * NPROJ + C_CZ + h * 256 + 8 * quad; bf16* op = MIX + grow * DM + 3072 + h * 256 + 8 * quad;
    v4u zz[8];
#pragma unroll
    for (int P2 = 0; P2 < 8; ++P2) zz[P2] = ldg16(zp + 32 * P2);
    __syncthreads();
    const LAS unsigned char* vb = F.lds + (4 * quad + tq) * 544 + 16 * tp;
#pragma unroll
    for (int P2 = 0; P2 < 8; ++P2) {
        f32x4 o0 = {0.f, 0.f, 0.f, 0.f}, o1 = {0.f, 0.f, 0.f, 0.f};
#pragma unroll
        for (int kp = 0; kp < 8; ++kp) { const LAS unsigned char* va = vb + (32 * kp) * 544 + 64 * P2;
            o0 = MFMA16(tr_frag(va, va + 16 * 544), pb[kp], o0);
            o1 = MFMA16(tr_frag(va + 8, va + 16 * 544 + 8), pb[kp], o1); }
        stg16(op + 32 * P2, gate_pack(o0, o1, inv, zz[P2]));
    }
    __syncthreads();
}

__device__ __forceinline__ void conv8(const v4u (&r)[4], const f32x4 (&w)[4][2], const f32x4 (&cb)[2], float oscale, v4u& o) {
    float y[8];
#pragma unroll
    for (int e = 0; e < 8; ++e) y[e] = cb[e >> 2][e & 3];
#pragma unroll
    for (int j = 0; j < 4; ++j) { const unsigned q[4] = {r[j].x, r[j].y, r[j].z, r[j].w};
#pragma unroll
        for (int e = 0; e < 8; ++e) { const float xv = (e & 1) ? bf2f(q[e >> 1] >> 16) : bf2f(q[e >> 1] & 0xffffu); y[e] += w[j][e >> 2][e & 3] * xv; } }
#pragma unroll
    for (int e = 0; e < 8; ++e) y[e] = y[e] * sigmoidf_(y[e]) * oscale;
    o.x = pk2(y[0], y[1]); o.y = pk2(y[2], y[3]); o.z = pk2(y[4], y[5]); o.w = pk2(y[6], y[7]);
}
__device__ __forceinline__ void cloc_item3(Frame& F, int item) {
    int tid = F.tid; asm volatile("" : "+v"(tid)); const int lane = tid & 63;
    const float* conv_w = in_ptr(F, 3); const float* conv_b = in_ptr(F, 4); bf16* PROJ = WSP(bf16, WS_PROJ); float* GATES = WSP(float, WS_GATES); float* CST = WSP(float, WS_SMALL);
    const int b = item >> 7, h = (item >> 5) & 3, c = item & 31;
    const int r0 = b * SEQ + c * 128;
    LAS unsigned char* V = F.lds; LAS unsigned char* KQ = F.lds + 69632;
    LAS float* LI = (LAS float*)(F.lds + 106496); LAS float* LF = LI + 128; LAS float* BB = LF + 128; LAS float* WW = BB + 128;
    {   v4u vt[8];
#pragma unroll
        for (int it = 0; it < 8; ++it) { const int idx = tid + 512 * it, l = idx >> 5, ch = idx & 31; vt[it] = ldg16(PROJ + (size_t)(r0 + l) * NPROJ + C_MV + h * 256 + ch * 8); }
        float li = 0.f, fp = 0.f;
        if (tid < 128) { li = GATES[(size_t)(r0 + tid) * 8 + h]; fp = GATES[(size_t)(r0 + tid) * 8 + 4 + h]; }
#pragma unroll
        for (int it = 0; it < 8; ++it) { const int idx = tid + 512 * it, l = idx >> 5, ch = idx & 31; *(LAS v4u*)(V + l * 544 + ch * 16) = vt[it]; }
        if (tid < 128) { v4u o1 = zero4(); o1.x = 0x3F80u; *(LAS v4u*)(V + tid * 544 + 512) = o1; *(LAS v4u*)(V + tid * 544 + 528) = zero4(); LI[tid] = li; LF[tid] = log_sigmoid_f(fp); }
    }
    __syncthreads();
    if (F.wave == 0) {
        wave_scan128<0>(LF, BB, lane);
        const float gl = __shfl(BB[2 * lane + 1], 63);
        const float a0 = gl - BB[2 * lane] + LI[2 * lane], a1 = gl - BB[2 * lane + 1] + LI[2 * lane + 1];
        float mx = fmaxf(a0, a1);
#pragma unroll
        for (int o = 1; o < 64; o <<= 1) mx = fmaxf(mx, __shfl_xor(mx, o));
        WW[2 * lane] = expf(a0 - mx); WW[2 * lane + 1] = expf(a1 - mx);
        if (lane == 0) { __hip_atomic_store(CST + item * 2, gl, RLX_AGENT); __hip_atomic_store(CST + item * 2 + 1, mx, RLX_AGENT); }
    }
    v4u kpk[4];
    {   const int ch = tid & 15;
        f32x4 wq[4][2], wk[4][2], bq[2], bk[2];
#pragma unroll
        for (int j = 0; j < 4; ++j) { const GAS f32x4* pq = (const GAS f32x4*)(conv_w + j * 1024 + h * 128 + ch * 8); const GAS f32x4* pk = (const GAS f32x4*)(conv_w + j * 1024 + 512 + h * 128 + ch * 8);
            wq[j][0] = pq[0]; wq[j][1] = pq[1]; wk[j][0] = pk[0]; wk[j][1] = pk[1]; }
        { const GAS f32x4* pq = (const GAS f32x4*)(conv_b + h * 128 + ch * 8); const GAS f32x4* pk = (const GAS f32x4*)(conv_b + 512 + h * 128 + ch * 8); bq[0] = pq[0]; bq[1] = pq[1]; bk[0] = pk[0]; bk[1] = pk[1]; }
#pragma unroll
        for (int i = 0; i < 4; ++i) { const int l = (tid >> 4) + 32 * i;
            v4u rq[4], rk[4];
#pragma unroll
            for (int j = 0; j < 4; ++j) { const int rr = l - 3 + j; rq[j] = zero4(); rk[j] = zero4();
                if (c > 0 || rr >= 0) { const bf16* src = PROJ + (size_t)(r0 + rr) * NPROJ + h * 128 + ch * 8; rq[j] = ldg16(src + C_MQ); rk[j] = ldg16(src + C_MK); } }
            v4u oq; conv8(rq, wq, bq, 1.0f, oq); conv8(rk, wk, bk, 0.08838834764831845f, kpk[i]);
            ws_store16_sc1(F, WS_MQK + ((size_t)(r0 + l) * 1024 + h * 128 + ch * 8) * 2, oq);
            ws_store16_sc1(F, WS_MQK + ((size_t)(r0 + l) * 1024 + 512 + h * 128 + ch * 8) * 2, kpk[i]); }
    }
    __syncthreads();
    {   const int ch = tid & 15;
#pragma unroll
        for (int i = 0; i < 4; ++i) { const int l = (tid >> 4) + 32 * i; const float w = WW[l]; const v4u k = kpk[i]; v4u o;
            o.x = pk2(bf2f(k.x & 0xffffu) * w, bf2f(k.x >> 16) * w); o.y = pk2(bf2f(k.y & 0xffffu) * w, bf2f(k.y >> 16) * w);
            o.z = pk2(bf2f(k.z & 0xffffu) * w, bf2f(k.z >> 16) * w); o.w = pk2(bf2f(k.w & 0xffffu) * w, bf2f(k.w >> 16) * w);
            *(LAS v4u*)(KQ + l * 288 + ch * 16) = o; } }
    __syncthreads();
    {   const int l15 = lane & 15, quad = lane >> 4, tq = (lane & 15) >> 2, tp = lane & 3;
        const LAS unsigned char* kb = KQ + (8 * quad + tq) * 288 + 8 * tp;
        const LAS unsigned char* vb = V + (8 * quad + tq) * 544 + 8 * tp;
        for (int vt = F.wave; vt < 17; vt += 8) {
            bf16x8 bfr[4];
#pragma unroll
            for (int ks = 0; ks < 4; ++ks) { const LAS unsigned char* p = vb + (32 * ks) * 544 + 32 * vt; bfr[ks] = tr_frag(p, p + 4 * 544); }
            const int v = 16 * vt + l15;
#pragma unroll
            for (int nt = 0; nt < 8; ++nt) { f32x4 a = {0.f, 0.f, 0.f, 0.f};
#pragma unroll
                for (int ks = 0; ks < 4; ++ks) { const LAS unsigned char* p = kb + (32 * ks) * 288 + 32 * nt; a = MFMA16(tr_frag(p, p + 4 * 288), bfr[ks], a); }
                if (v < 257) ws_store16_sc1(F, WS_CLOC + ((size_t)item * (257 * 128) + (size_t)v * 128 + 16 * nt + 4 * quad) * 4, __builtin_bit_cast(v4u, a)); }
        }
    }
    asm volatile("s_waitcnt vmcnt(0)" ::: "memory");
    __syncthreads();
    if (tid == 0) __hip_atomic_fetch_add(F.ctl + CW_CLOCDONE, 1u, RLX_AGENT);
}

__device__ __forceinline__ void mout_item3(Frame& F, int item) {
    int tid = F.tid; asm volatile("" : "+v"(tid)); const int lane = tid & 63;
    const float* m_norm_g = in_ptr(F, 7); bf16* PROJ = WSP(bf16, WS_PROJ); bf16* MQK = WSP(bf16, WS_MQK); bf16* CPREV = WSP(bf16, WS_CPREV); float* GATES = WSP(float, WS_GATES); float* MPREV = WSP(float, WS_SMALL + 4096); bf16* MIX = WSP(bf16, WS_MIX);
    const int b = item >> 7, h = (item >> 5) & 3, c = item & 31;
    const int r0 = b * SEQ + c * 128;
    LAS unsigned char* V = F.lds; LAS unsigned char* CP = F.lds + 69632;
    LAS float* LI = (LAS float*)(F.lds + 143616); LAS float* LF = LI + 128; LAS float* BB = LF + 128; LAS float* UU = BB + 128; LAS float* MM = UU + 128;
    const float mprev = MPREV[item];
    {   v4u vt[8], ct[9];
#pragma unroll
        for (int it = 0; it < 8; ++it) { const int idx = tid + 512 * it, l = idx >> 5, ch = idx & 31; vt[it] = ldg16(PROJ + (size_t)(r0 + l) * NPROJ + C_MV + h * 256 + ch * 8); }
#pragma unroll
        for (int it = 0; it < 9; ++it) { const int idx = tid + 512 * it, row = idx >> 4, ch = idx & 15; ct[it] = zero4();
            if (row < 257) ct[it] = ldg16(CPREV + (size_t)item * (257 * 128) + row * 128 + ch * 8); }
        float li = 0.f, fp = 0.f;
        if (tid < 128) { li = GATES[(size_t)(r0 + tid) * 8 + h]; fp = GATES[(size_t)(r0 + tid) * 8 + 4 + h]; }
#pragma unroll
        for (int it = 0; it < 8; ++it) { const int idx = tid + 512 * it, l = idx >> 5, ch = idx & 31; *(LAS v4u*)(V + l * 544 + ch * 16) = vt[it]; }
#pragma unroll
        for (int it = 0; it < 9; ++it) { const int idx = tid + 512 * it, row = idx >> 4, ch = idx & 15; if (row < 272) *(LAS v4u*)(CP + row * 272 + ch * 16) = ct[it]; }
        if (tid < 128) { v4u o1 = zero4(); o1.x = 0x3F80u; *(LAS v4u*)(V + tid * 544 + 512) = o1; *(LAS v4u*)(V + tid * 544 + 528) = zero4(); LI[tid] = li; LF[tid] = log_sigmoid_f(fp); }
    }
    __syncthreads();
    const int l15 = lane & 15, quad = lane >> 4, tq = (lane & 15) >> 2, tp = lane & 3, t0 = 16 * F.wave;
    const int t = t0 + l15;
    const size_t grow = (size_t)(r0 + t);
    bf16x8 qf[4], kf[8][4];
    { const bf16* qp = MQK + grow * 1024 + h * 128 + 8 * quad;
#pragma unroll
      for (int ks = 0; ks < 4; ++ks) qf[ks] = __builtin_bit_cast(bf16x8, ldg16(qp + 32 * ks)); }
#pragma unroll
    for (int st = 0; st < 8; ++st) { const bf16* kp = MQK + (size_t)(r0 + 16 * st + l15) * 1024 + 512 + h * 128 + 8 * quad;
#pragma unroll
        for (int ks = 0; ks < 4; ++ks) kf[st][ks] = __builtin_bit_cast(bf16x8, ldg16(kp + 32 * ks)); }
    if (F.wave == 0) {
        wave_scan128<0>(LF, BB, lane);
        UU[2 * lane] = LI[2 * lane] - BB[2 * lane]; UU[2 * lane + 1] = LI[2 * lane + 1] - BB[2 * lane + 1];
        wave_scan128<1>(UU, MM, lane);
        MM[2 * lane] = fmaxf(MM[2 * lane], mprev); MM[2 * lane + 1] = fmaxf(MM[2 * lane + 1], mprev);
    }
    __syncthreads();
    const float Mt = MM[t], mt = BB[t] + Mt;
    bf16x8 sb[4], qb[4];
    {
        f32x4 sT[8];
#pragma unroll
        for (int st = 0; st < 8; ++st) { f32x4 a = {0.f, 0.f, 0.f, 0.f};
#pragma unroll
            for (int ks = 0; ks < 4; ++ks) a = MFMA16(kf[st][ks], qf[ks], a);
#pragma unroll
            for (int r = 0; r < 4; ++r) { const int s = 16 * st + 4 * quad + r; a[r] = (s <= t) ? a[r] * fast_exp(UU[s] - Mt) : 0.f; }
            sT[st] = a; }
#pragma unroll
        for (int kp = 0; kp < 4; ++kp) { const f32x4 p0 = sT[2 * kp], p1 = sT[2 * kp + 1];
            sb[kp] = mk_frag(pg8::cvt_pk_bf16(p0[0], p0[1]), pg8::cvt_pk_bf16(p0[2], p0[3]), pg8::cvt_pk_bf16(p1[0], p1[1]), pg8::cvt_pk_bf16(p1[2], p1[3])); }
        const float wi = fast_exp(mprev - Mt);
#pragma unroll
        for (int ks = 0; ks < 4; ++ks) { const v4u q = __builtin_bit_cast(v4u, qf[ks]);
            qb[ks] = mk_frag(pg8::cvt_pk_bf16(bf2f(q.x & 0xffffu) * wi, bf2f(q.x >> 16) * wi), pg8::cvt_pk_bf16(bf2f(q.y & 0xffffu) * wi, bf2f(q.y >> 16) * wi),
                             pg8::cvt_pk_bf16(bf2f(q.z & 0xffffu) * wi, bf2f(q.z >> 16) * wi), pg8::cvt_pk_bf16(bf2f(q.w & 0xffffu) * wi, bf2f(q.w >> 16) * wi)); }
    }
    const bf16* op = PROJ + grow * NPROJ + C_MO + h * 256 + 8 * quad; const bf16* zp = PROJ + grow * NPROJ + C_MZ + h * 256 + 8 * quad;
    v4u og[8], zz[8];
#pragma unroll
    for (int P2 = 0; P2 < 8; ++P2) { og[P2] = ldg16(op + 32 * P2); zz[P2] = ldg16(zp + 32 * P2); }
    const LAS unsigned char* vb = V + (4 * quad + tq) * 544 + 16 * tp;
    const LAS unsigned char* cb = CP + (8 * (l15 >> 2) + (l15 & 3)) * 272 + 16 * quad;
    f32x4 num[16]; float den;
    {   f32x4 a = {0.f, 0.f, 0.f, 0.f};
        const LAS unsigned char* vd = V + (4 * quad + tq) * 544 + 512 + 8 * tp; const LAS unsigned char* cd = CP + (256 + l15) * 272 + 16 * quad;
#pragma unroll
        for (int kp = 0; kp < 4; ++kp) { const LAS unsigned char* p = vd + (32 * kp) * 544; a = MFMA16(tr_frag(p, p + 16 * 544), sb[kp], a); }
#pragma unroll
        for (int ks = 0; ks < 4; ++ks) a = MFMA16(ld_frag16(cd + 64 * ks), qb[ks], a);
        den = __shfl(a[0], l15); }
#pragma unroll
    for (int P2 = 0; P2 < 8; ++P2)
#pragma unroll
        for (int hf = 0; hf < 2; ++hf) { f32x4 a = {0.f, 0.f, 0.f, 0.f};
#pragma unroll
            for (int kp = 0; kp < 4; ++kp) { const LAS unsigned char* p = vb + (32 * kp) * 544 + 64 * P2 + 8 * hf; a = MFMA16(tr_frag(p, p + 16 * 544), sb[kp], a); }
            const LAS unsigned char* cp = cb + (32 * P2 + 4 * hf) * 272;
#pragma unroll
            for (int ks = 0; ks < 4; ++ks) a = MFMA16(ld_frag16(cp + 64 * ks), qb[ks], a);
            num[2 * P2 + hf] = a; }
    const float inv = 1.0f / fmaxf(fabsf(den), expf(-mt));
    float s = 0.f;
#pragma unroll
    for (int P2 = 0; P2 < 8; ++P2) { const v4u o = og[P2];
        f32x4& a = num[2 * P2]; f32x4& bq = num[2 * P2 + 1];
        a[0] *= inv * bf2f(o.x & 0xffffu); a[1] *= inv * bf2f(o.x >> 16); a[2] *= inv * bf2f(o.y & 0xffffu); a[3] *= inv * bf2f(o.y >> 16);
        bq[0] *= inv * bf2f(o.z & 0xffffu); bq[1] *= inv * bf2f(o.z >> 16); bq[2] *= inv * bf2f(o.w & 0xffffu); bq[3] *= inv * bf2f(o.w >> 16);
        s += (a[0] + a[1]) + (a[2] + a[3]) + (bq[0] + bq[1]) + (bq[2] + bq[3]); }
    const float mean = quad_sum(s) * (1.0f / 256.0f);
    float q2 = 0.f;
#pragma unroll
    for (int i = 0; i < 16; ++i) { num[i] = num[i] - mean; q2 += (num[i][0] * num[i][0] + num[i][1] * num[i][1]) + (num[i][2] * num[i][2] + num[i][3] * num[i][3]); }
    const float rstd = 1.0f / sqrtf(quad_sum(q2) * (1.0f / 256.0f) + HEAD_NORM_EPS);
    const float* ng = m_norm_g + h * 256 + 8 * quad; bf16* mp = MIX + grow * DM + 2048 + h * 256 + 8 * quad;
#pragma unroll
    for (int P2 = 0; P2 < 8; ++P2) {
        const f32x4 g0 = *(const GAS f32x4*)(ng + 32 * P2), g1 = *(const GAS f32x4*)(ng + 32 * P2 + 4);
        stg16(mp + 32 * P2, gate_pack(num[2 * P2] * g0, num[2 * P2 + 1] * g1, rstd, zz[P2])); }
    __syncthreads();
}

__device__ __forceinline__ void ln_phase(Frame& F, float inject) {
    const float* x = in_ptr(F, 0); const float* ln_g = in_ptr(F, 12); const float* ln_b = in_ptr(F, 13); float* out = out_ptr(F); bf16* Y = WSP(bf16, WS_Y);
    const int gw = F.vcu * NWAVES + F.wave, NGW = F.G * NWAVES;
    for (int m = gw; m < MROWS; m += NGW) {
        const GAS f32x4* xr = (const GAS f32x4*)(x + (size_t)m * DM) + F.lane;
        const GAS v2u* yr = (const GAS v2u*)(Y + (size_t)m * DM) + F.lane;
        f32x4 v[16]; float s = 0.f;
#pragma unroll
        for (int j = 0; j < 16; ++j) { const f32x4 xv = xr[64 * j]; const v2u yv = yr[64 * j];
            v[j].x = DEEPNORM_ALPHA * xv.x + bf2f(yv.x & 0xffffu); v[j].y = DEEPNORM_ALPHA * xv.y + bf2f(yv.x >> 16);
            v[j].z = DEEPNORM_ALPHA * xv.z + bf2f(yv.y & 0xffffu); v[j].w = DEEPNORM_ALPHA * xv.w + bf2f(yv.y >> 16);
            s += (v[j].x + v[j].y) + (v[j].z + v[j].w); }
        const float mean = wave_sum(s) * (1.0f / DM); float s2 = 0.f;
#pragma unroll
        for (int j = 0; j < 16; ++j) { v[j] = v[j] - mean; s2 += (v[j].x * v[j].x + v[j].y * v[j].y) + (v[j].z * v[j].z + v[j].w * v[j].w); }
        const float rstd = 1.0f / sqrtf(wave_sum(s2) * (1.0f / DM) + LN_EPS);
        GAS f32x4* orow = (GAS f32x4*)(out + (size_t)m * DM) + F.lane;
        const GAS f32x4* gr = (const GAS f32x4*)ln_g + F.lane; const GAS f32x4* br = (const GAS f32x4*)ln_b + F.lane;
        const float inj = (m == gw) ? inject : 0.f;
#pragma unroll
        for (int j = 0; j < 16; ++j) orow[64 * j] = v[j] * rstd * gr[64 * j] + br[64 * j] + inj;
    }
}

#ifndef MK_N_LAUNCHES
#define MK_N_LAUNCHES 1
#endif
constexpr int N_PHASES = 4;
struct Args { const float* in[14]; float* out; unsigned char* ws; int ph_lo, ph_hi; };
__global__ void __launch_bounds__(NWAVES * 64, 2) hymba_fwd(Args args) {
    extern __shared__ __attribute__((aligned(16))) unsigned char lds[];
    Frame F;
    F.lds = (LAS unsigned char*)lds;
    F.MISC = (volatile LAS unsigned*)(F.lds + MISC_OFF);
    F.tid = threadIdx.x; F.lane = F.tid & 63; F.wave = __builtin_amdgcn_readfirstlane(F.tid >> 6);
    F.G = gridDim.x; { const int bx = blockIdx.x; F.vcu = (F.G % 8 == 0) ? (bx % 8) * (F.G / 8) + bx / 8 : bx; }
    F.ws = args.ws; F.ctl = (gu32*)(args.ws + WS_CTL); F.kargs = (const CAS unsigned char*)__builtin_amdgcn_kernarg_segment_ptr();
    if (F.tid < 64) ((LAS unsigned*)(F.lds + MISC_OFF))[F.tid] = 0u;
    __syncthreads();
    const int lo = args.ph_lo, hi = args.ph_hi;
#ifdef PROBE_A
#define STAMP(k) do { __syncthreads(); if (F.tid == 0) F.MISC[20 + (k)] = (unsigned)__builtin_amdgcn_s_memrealtime(); __syncthreads(); } while (0)
#else
#define STAMP(k) do { } while (0)
#endif
    STAMP(0);
    XcdBarrier bar; bar.bar = (unsigned*)(F.ctl + CW_BAR); bar.x = 0; bar.st = nullptr;
    if (hi - lo > 1) bar = xcd_barrier_post((unsigned*)(F.ctl + CW_BAR), F.MISC + 8);
#ifdef ONLY_PHASE
#define IN(k) ((k) == ONLY_PHASE)
#else
#define IN(k) (lo <= (k) && (k) < hi)
#endif
#define BOTH(k) (IN(k) && IN((k) + 1))
    if (IN(0)) { p0_prologue(F); STAMP(10); if (BOTH(0)) xcd_barrier(bar); }
    STAMP(1);
    if (IN(1)) {
        gu32* early = F.ctl + CW_EARLY; gu32* qhead = F.ctl + CW_QHEAD;
        {   pg8::Gemm g{WSP(bf16, WS_ACAT), WSP(bf16, WS_BTCAT), MROWS + MEMROWS, NPROJ + 2048, DM}; pg8::InProjOrder S; S.G = F.G; S.c = (int)blockIdx.x; S.early = (unsigned*)early;
            pg8::EpiProj E{WSP(bf16, WS_PROJ), NPROJ, WSP(bf16, WS_MKV), 2048};
            pg8::gemm_phase<pg8::EpiProj, pg8::InProjOrder, false, true>(F.lds, g, S, E); }
        STAMP(2);
        constexpr int Q_W = 128, Q_CLOC = Q_W + 256, Q_SWA1 = Q_CLOC + 64, Q_SCAN = Q_SWA1 + 65, Q_SWA2 = Q_SCAN + 192, Q_CROSS = Q_SWA2 + 256, Q_MOUT = Q_CROSS + 256, Q_END = Q_MOUT;
        int acq = 0;
        unsigned qpre = 0xffffffffu;
        for (;;) {
            if (F.tid == 0) F.MISC[16] = (qpre != 0xffffffffu) ? qpre : __hip_atomic_fetch_add(qhead, 1u, RLX_AGENT);
            __syncthreads();
            const int q = (int)F.MISC[16];
            __syncthreads();
            if (q >= Q_END) break;
            if (F.tid == 0) qpre = (q < Q_END - 640) ? __hip_atomic_fetch_add(qhead, 1u, RLX_AGENT) : 0xffffffffu;
            const int need = q < Q_W ? 0 : (q < Q_SWA1 ? 1 : (q < Q_SCAN ? 2 : (q < Q_CROSS ? 1 : 3)));
            if (acq < need) { if (need == 3) STAMP(14); if (need == 2) STAMP(16);
                if (F.tid == 0) {
#ifdef PROBE_STALL
                    const unsigned t0_ = (unsigned)__builtin_amdgcn_s_memrealtime();
#endif
                    gu32* w = need == 1 ? early : (need == 2 ? F.ctl + CW_CLOCDONE : F.ctl + CW_SCANDONE);
                    const unsigned want = need == 1 ? (unsigned)F.G * NWAVES : (need == 2 ? 256u : 65u); unsigned sp = 0;
                    while (__hip_atomic_load(w, RLX_AGENT) < want) { __builtin_amdgcn_s_sleep(4); if (++sp > (1u << 23)) break; }
                    if (need == 3) while (__hip_atomic_load(F.ctl + CW_LATE, RLX_AGENT) < 144u * NWAVES) { __builtin_amdgcn_s_sleep(4); if (++sp > (1u << 23)) break; }
                    __builtin_amdgcn_fence(__ATOMIC_ACQUIRE, "agent"); asm volatile("s_waitcnt vmcnt(0)" ::: "memory");
#ifdef PROBE_STALL
                    __hip_atomic_fetch_add(F.ctl + 448 + 64 * need, (unsigned)__builtin_amdgcn_s_memrealtime() - t0_, RLX_AGENT);
#endif
                }
                __syncthreads();
                acq = need;
                if (need == 1) STAMP(3); if (need == 3) STAMP(15); if (need == 2) STAMP(17);
            }
            if (q < Q_W) wout_item(F, q);
            else if (q < Q_CLOC) cloc_item3(F, q - Q_W);
            else if (q < Q_SWA1) swa_item4(F, q - Q_CLOC);
            else if (q < Q_SCAN) scan_item(F, q - Q_SWA1);
            else if (q < Q_SWA2) swa_item4(F, q - Q_SCAN + 64);
            else if (q < Q_CROSS) cross_item3(F, q - Q_SWA2);
            else mout_item3(F, q - Q_CROSS);
        }
        STAMP(4);
        if (BOTH(1)) xcd_barrier(bar);
    }
    STAMP(5); STAMP(6); STAMP(7);
    if (IN(2)) {
        pg8::Gemm g{WSP(bf16, WS_MIX), WSP(bf16, WS_WOT), MROWS, DM, DM}; pg8::StaticOrder S; S.init(MROWS, DM, F.G, (int)blockIdx.x);
        pg8::EpiY E{WSP(bf16, WS_Y), DM};
        pg8::gemm_phase<pg8::EpiY, pg8::StaticOrder, false, true>(F.lds, g, S, E);
        STAMP(13);
        if (BOTH(2)) xcd_barrier(bar);
    }
    STAMP(8);
    float inject = 0.f;
#ifdef PROBE_STALL
    if ((int)blockIdx.x == 0) { const unsigned tot = __hip_atomic_load(F.ctl + 448 + 64 * PROBE_STALL, RLX_AGENT); inject = sqrtf(5.12e-3f * ((float)tot * 0.01f / 256.0f) / (float)(PROBE_FULL)); }
#endif
#ifdef PROBE_A
    STAMP(9);
    if ((int)blockIdx.x == PROBE_BLK) { const unsigned dt = F.MISC[20 + PROBE_B] - F.MISC[20 + PROBE_A]; inject = sqrtf(5.12e-3f * ((float)dt * 0.01f) / (float)(PROBE_FULL)); }
#endif
    if (IN(3)) ln_phase(F, inject);
#undef IN
#undef BOTH
}

extern "C" void kernel_launch(void* const* d_in, const int* in_sizes, int n_in, void* d_out, int out_size, void* d_ws, size_t ws_size, hipStream_t stream) {
    static int grid = 0;
    if (grid == 0) {
        if (n_in != 14 || in_sizes[0] != MROWS * DM || out_size != MROWS * DM || ws_size < WS_END) { fprintf(stderr, "kernel_launch: unexpected shapes (n_in %d, in0 %d, out %d, ws %zu); nothing launched\n", n_in, n_in > 0 ? in_sizes[0] : -1, out_size, ws_size); grid = -1; return; }
        int dev = 0, cus = 0, per_cu = 0;
        if (hipGetDevice(&dev) != hipSuccess || hipDeviceGetAttribute(&cus, hipDeviceAttributeMultiprocessorCount, dev) != hipSuccess) { grid = -1; return; }
        if (hipFuncSetAttribute((const void*)hymba_fwd, hipFuncAttributeMaxDynamicSharedMemorySize, LDS_BYTES) != hipSuccess) { fprintf(stderr, "kernel_launch: hipFuncSetAttribute failed\n"); grid = -1; return; }
        if (hipOccupancyMaxActiveBlocksPerMultiprocessor(&per_cu, (const void*)hymba_fwd, NWAVES * 64, LDS_BYTES) != hipSuccess || per_cu < 1) { fprintf(stderr, "kernel_launch: occupancy query says %d blocks per CU; nothing launched\n", per_cu); (void)hipGetLastError(); grid = -1; return; }
        grid = cus;
    }
    if (grid < 0) return;
    (void)hipMemsetAsync((char*)d_ws + WS_CTL, 0, CTL_ZERO_BYTES, stream);
    Args a{};
    for (int i = 0; i < 14; ++i) a.in[i] = (const float*)d_in[i];
    a.out = (float*)d_out; a.ws = (unsigned char*)d_ws;
#if MK_N_LAUNCHES == 1
    a.ph_lo = 0; a.ph_hi = N_PHASES;
    void* kargs[] = {&a};
    const hipError_t le = hipLaunchCooperativeKernel((const void*)hymba_fwd, dim3(grid), dim3(NWAVES * 64), kargs, LDS_BYTES, stream);
    if (le != hipSuccess) fprintf(stderr, "kernel_launch: cooperative launch failed: %s (grid %d)\n", hipGetErrorString(le), grid);
#ifdef PROBE_EXTRA
    a.ph_lo = PROBE_EXTRA; a.ph_hi = PROBE_EXTRA + 1; hipLaunchKernelGGL(hymba_fwd, dim3(grid), dim3(NWAVES * 64), LDS_BYTES, stream, a);
#endif
#else
    for (int p = 0; p < N_PHASES; ++p) { a.ph_lo = p; a.ph_hi = p + 1; hipLaunchKernelGGL(hymba_fwd, dim3(grid), dim3(NWAVES * 64), LDS_BYTES, stream, a); }
#endif
}
```

```cpp
#include <hip/hip_runtime.h>
#include <cstdio>
#include <cstdint>
#include <cstddef>
namespace pg8 {
#define PG8_LAS __attribute__((address_space(3)))
typedef unsigned short bf16_t;
typedef short bf16x8 __attribute__((ext_vector_type(8)));
typedef float f32x4 __attribute__((ext_vector_type(4)));
typedef unsigned u32x4 __attribute__((ext_vector_type(4)));
constexpr int BM = 256, BK = 64, HALF = 128, HTB = HALF * BK * 2  , STAGE_BYTES = 8 * HTB, NXCD = 8, WGM = 8;

__host__ __device__ __forceinline__ int lds_byte(int r, int c) { const int st = (r >> 4) * 2 + (c >> 5), rr = r & 15, cc = c & 31, ob = rr * 64 + cc * 2; return st * 1024 + (ob ^ (((ob >> 9) & 1) << 5)); }
__host__ __device__ __forceinline__ void stage_rc(int b, int& R, int& C) { const int st = b / 1024, sb = b % 1024, swz = sb ^ (((sb >> 9) & 1) << 5); R = (st >> 1) * 16 + swz / 64; C = (st & 1) * 32 + (swz % 64) / 2; }
__host__ __device__ __forceinline__ int perm32(int rho) { const int n = rho >> 4, i = rho & 15; return 8 * (i >> 2) + 4 * n + (i & 3); }

typedef int v8i_t __attribute__((ext_vector_type(8)));
typedef int v4i_t __attribute__((ext_vector_type(4)));
__device__ __forceinline__ v8i_t cat8(bf16x8 a, bf16x8 b) { return __builtin_shufflevector(__builtin_bit_cast(v4i_t, a), __builtin_bit_cast(v4i_t, b), 0, 1, 2, 3, 4, 5, 6, 7); }
__device__ __forceinline__ int lane_now() { int l; asm volatile("v_mbcnt_lo_u32_b32 %0, -1, 0\n\tv_mbcnt_hi_u32_b32 %0, -1, %0" : "=v"(l)); return l; }
struct Unit { int pm, pn, tag, f8; };
struct Gemm { const void* base; unsigned A, Bt; int M, N, K; unsigned A8; int nt8; unsigned pitch; };
#ifndef F8_VARIANT
#define F8_VARIANT 28
#endif
#if F8_VARIANT == 28
#define F8MASK 0x00000FF0000FFFFFull
#else
#define F8MASK 0x00000FF0000FF0FFull
#endif
constexpr unsigned long long F8_TILES = F8MASK;

struct StaticOrder {
    int nM, nN, nwg, G, c, f8;
    __host__ __device__ void init(int M, int N, int G_, int c_, int f8_) { nM = M / BM; nN = N / BM; nwg = nM * nN; G = G_; c = c_; f8 = f8_; }
    __host__ __device__ bool next(int i, Unit& u) const {
        const long L = (long)i * G + c; if (L >= nwg) return false;
        int wgid = (int)L; { const int q = nwg / NXCD, r = nwg % NXCD, xcd = wgid % NXCD, off = wgid / NXCD; wgid = (xcd < r ? xcd * (q + 1) : r * (q + 1) + (xcd - r) * q) + off; }
        const int nig = WGM * nN, gid = wgid / nig, fm = gid * WGM, gsz = (nM - fm) < WGM ? (nM - fm) : WGM;
        u.pm = fm + ((wgid % nig) % gsz); u.pn = (wgid % nig) / gsz; u.tag = 0; u.f8 = f8; return true;
    }
    __device__ __forceinline__ void a_ready(const Unit&) const {}
    __device__ __forceinline__ void done(const Unit&) const {}
};
__device__ __forceinline__ unsigned cvt_pk_bf16(float lo, float hi) { unsigned r; asm volatile("v_cvt_pk_bf16_f32 %0, %1, %2" : "=v"(r) : "v"(lo), "v"(hi)); return r; }
typedef float f32x2 __attribute__((ext_vector_type(2)));
__device__ __forceinline__ float sigmoid_f(float v) { return __builtin_amdgcn_rcpf(1.0f + __builtin_amdgcn_exp2f(-1.4426950408889634f * v)); }
struct EpiProj {
    static constexpr bool PERM = true, AFTER_DRAIN = false;
    bf16_t* P; int ldp; bf16_t* MKV; int ldm;
    __device__ __forceinline__ void operator()(const f32x4 (&acc)[2][2][4][2], const Unit& u, int wr, int wc, int fr, int fq) const {
        bf16_t* tbase; unsigned tbytes; unsigned boff; int ld; int act = 0;
        if (u.pm < 32) { tbase = P; tbytes = 8192u * 11264u * 2u; boff = (unsigned)(u.pm * BM) * (unsigned)ldp + (unsigned)(u.pn * BM); ld = ldp; const int pn = u.pn;
            act = ((pn >= 12 && pn < 20) || (pn >= 32 && pn < 36) || pn >= 40) ? 1 : ((pn >= 28 && pn < 32) ? 2 : 0); }
        else { tbase = MKV; tbytes = 512u * 2048u * 2u; boff = (unsigned)((u.pm - 32) * BM) * (unsigned)ldm + (unsigned)((u.pn - 44) * BM); ld = ldm; }
        const __amdgpu_buffer_rsrc_t rsrc = __builtin_amdgcn_make_buffer_rsrc(tbase, 0, tbytes, 0x00020000);
        const int row0 = wr * 64 + fr, col0 = wc * 32 + 8 * fq;
        const float osc = u.f8 ? (1.0f / 64.0f) : 1.0f;
#pragma unroll
        for (int ai = 0; ai < 2; ++ai)
#pragma unroll
            for (int m = 0; m < 4; ++m) { const unsigned rowoff = (boff + (unsigned)(row0 + ai * HALF + m * 16) * (unsigned)ld + (unsigned)col0) * 2u;
#pragma unroll
                for (int bj = 0; bj < 2; ++bj) { f32x4 v0 = acc[ai][bj][m][0] * osc, v1 = acc[ai][bj][m][1] * osc;
                    if (act == 1) {
#pragma unroll
                        for (int j = 0; j < 4; ++j) { v0[j] = v0[j] * sigmoid_f(v0[j]); v1[j] = v1[j] * sigmoid_f(v1[j]); } }
                    else if (act == 2) {
#pragma unroll
                        for (int j = 0; j < 4; ++j) { v0[j] = sigmoid_f(v0[j]); v1[j] = sigmoid_f(v1[j]); } }
                    u32x4 w; w.x = cvt_pk_bf16(v0[0], v0[1]); w.y = cvt_pk_bf16(v0[2], v0[3]); w.z = cvt_pk_bf16(v1[0], v1[1]); w.w = cvt_pk_bf16(v1[2], v1[3]);
                    __builtin_amdgcn_raw_buffer_store_b128(w, rsrc, rowoff + (unsigned)(bj * HALF * 2), 0, 18  ); } }
    }
};
#ifndef Y_STORE_AUX
#define Y_STORE_AUX 0
#endif
struct EpiY {
    static constexpr bool PERM = true, AFTER_DRAIN = false;
    bf16_t* O; int ldc;
    __device__ __forceinline__ void operator()(const f32x4 (&acc)[2][2][4][2], const Unit& u, int wr, int wc, int fr, int fq) const {
        const __amdgpu_buffer_rsrc_t rsrc = __builtin_amdgcn_make_buffer_rsrc(O, 0, 8192u * 4096u * 2u, 0x00020000);
        const unsigned boff = (unsigned)(u.pm * BM) * (unsigned)ldc + (unsigned)(u.pn * BM);
        const int row0 = wr * 64 + fr, col0 = wc * 32 + 8 * fq;
#pragma unroll
        for (int ai = 0; ai < 2; ++ai)
#pragma unroll
            for (int m = 0; m < 4; ++m) { const unsigned rowoff = (boff + (unsigned)(row0 + ai * HALF + m * 16) * (unsigned)ldc + (unsigned)col0) * 2u;
#pragma unroll
                for (int bj = 0; bj < 2; ++bj) { const f32x4 v0 = acc[ai][bj][m][0] * (1.0f / 4096.0f), v1 = acc[ai][bj][m][1] * (1.0f / 4096.0f);
                    u32x4 w; w.x = cvt_pk_bf16(v0[0], v0[1]); w.y = cvt_pk_bf16(v0[2], v0[3]); w.z = cvt_pk_bf16(v1[0], v1[1]); w.w = cvt_pk_bf16(v1[2], v1[3]);
                    __builtin_amdgcn_raw_buffer_store_b128(w, rsrc, rowoff + (unsigned)(bj * HALF * 2), 0, Y_STORE_AUX); } }
    }
};
struct InProjOrder {
    int G, c; unsigned* early;
    static constexpr int NS = 6, PS = 3;
    __device__ __forceinline__ bool next(int i, Unit& u) const {
        const int xcd = c & 7, odd = xcd & 1, j = c >> 3, cq = j >> 3;
        const bool memkv = (j == 16 || j == 17), skip = (cq >= 2) && !memkv;
        const int s = (skip && i >= PS) ? i + 1 : i;
        if (s >= NS) return false;
        u.tag = (s == NS - 1) ? 2 : (s == NS - 2 ? 1 : 0);
        u.pm = 8 * (xcd >> 1) + (j & 7);
        if (s == PS && cq >= 2) { const int k = xcd * 2 + (j - 16); u.pm = 32 + (k >> 3); u.pn = 44 + (k & 7); u.f8 = 1; return true; }
#if F8_VARIANT == 28
        if (s < 4) { const int idx = 4 * s + cq; u.pn = odd ? (idx < 6 ? 14 + idx : 30 + idx) : idx; }
        else if (s == 4) u.pn = (odd ? 24 : 20) + cq;
#else
        if (s < 3) { const int idx = 4 * s + cq; u.pn = odd ? (idx < 4 ? 16 + idx : 32 + idx) : (idx < 8 ? idx : idx + 4); }
        else if (s == 3) u.pn = (odd ? 10 : 8) + cq;
        else if (s == 4) u.pn = (odd ? 24 : 20) + cq;
#endif
        else u.pn = (odd ? 32 : 28) + cq;
        u.f8 = (int)((F8_TILES >> u.pn) & 1ull);
        return true;
    }
    __device__ __forceinline__ void a_ready(const Unit&) const {}
    __device__ __forceinline__ void done(const Unit& u) const {
        if (u.tag) {
            asm volatile("s_waitcnt vmcnt(0)" ::: "memory");
            if (lane_now() == 0) __hip_atomic_fetch_add(u.tag == 1 ? early : early + 64, 1u, __ATOMIC_RELAXED, __HIP_MEMORY_SCOPE_AGENT);
        }
    }
};
template <class Epi, class Sched, bool ALIGN_EPI = false, bool SP2 = false, int MIXK = 0>
__device__ __forceinline__ void gemm_phase(PG8_LAS unsigned char* lds, const Gemm g, const Sched& S, const Epi& E, const int wid  ) {
    const int lane = lane_now(), tid = wid * 64 + lane, wr = wid >> 2, wc = wid & 3, fr = lane & 15, fq = lane >> 4;
    static_assert(SP2, "only the two-super-phase K loop is kept");
    const int K = g.K, nt = K / BK, nt8 = g.nt8;
    unsigned voffA[2], voffB[2];
#pragma unroll
    for (int i = 0; i < 2; ++i) { int R, C; stage_rc(tid * 16 + i * 8192, R, C); const int Rb = Epi::PERM ? ((R & ~31) + perm32(R & 31)) : R;
        voffA[i] = (unsigned)R * g.pitch + (unsigned)C * 2u; voffB[i] = (unsigned)Rb * g.pitch + (unsigned)C * 2u; }
    const __amdgpu_buffer_rsrc_t srs = __builtin_amdgcn_make_buffer_rsrc((void*)g.base, 0, 0x7ffffff0, 0x00020000);
    const unsigned kstep = (unsigned)(BK * 2);
    const unsigned hstep = (unsigned)HALF * g.pitch;
    const unsigned tstep = 2 * hstep;
    const unsigned ldsw = (unsigned)wid * 1024u;
    const int aoff = lds_byte(wr * 64 + fr, fq * 8), boff = lds_byte(wc * 32 + fr, fq * 8);
#define PG8_SA(b, h) (((b) * 2 + (h)) * HTB)
#define PG8_SB(b, h) ((4 + (b) * 2 + (h)) * HTB)
#define PG8_STAGE(bufoff, gbase, voff) do { _Pragma("unroll") for (int _i = 0; _i < 2; ++_i) \
        __builtin_amdgcn_raw_ptr_buffer_load_lds(srs, (PG8_LAS unsigned*)(lds + (bufoff) + ldsw + _i * 8192), 16, (int)(voff)[_i], (int)(gbase), 0, 0); } while (0)
#define PG8_LDA(dst, b, h) do { _Pragma("unroll") for (int m = 0; m < 4; ++m) _Pragma("unroll") for (int k = 0; k < 2; ++k) dst[m][k] = *(const PG8_LAS bf16x8*)(lds + PG8_SA(b, h) + aoff + m * 2048 + k * 1024); } while (0)
#define PG8_LDB(dst, b, h) do { _Pragma("unroll") for (int n = 0; n < 2; ++n) _Pragma("unroll") for (int k = 0; k < 2; ++k) dst[n][k] = *(const PG8_LAS bf16x8*)(lds + PG8_SB(b, h) + boff + n * 2048 + k * 1024); } while (0)
#define PG8_MMA(ai, bj, At, Bt) do { __builtin_amdgcn_s_setprio(1); _Pragma("unroll") for (int m = 0; m < 4; ++m) _Pragma("unroll") for (int n = 0; n < 2; ++n) _Pragma("unroll") for (int k = 0; k < 2; ++k) \
        acc[ai][bj][m][n] = __builtin_amdgcn_mfma_f32_16x16x32_bf16(Bt[n][k], At[m][k], acc[ai][bj][m][n], 0, 0, 0); __builtin_amdgcn_s_setprio(0); } while (0)
#define PG8_WAIT_V(n) asm volatile("s_waitcnt vmcnt(" #n ")" ::: "memory")
#define PG8_WAIT_L(n) asm volatile("s_waitcnt lgkmcnt(" #n ")" ::: "memory")
#define PG8_BAR __builtin_amdgcn_s_barrier()
#define PG8_SCHED __builtin_amdgcn_sched_barrier(0)
#define PG8_MMA8(ai, bj, At, Bt) do { __builtin_amdgcn_s_setprio(1); _Pragma("unroll") for (int m = 0; m < 4; ++m) _Pragma("unroll") for (int n = 0; n < 2; ++n) \
        acc[ai][bj][m][n] = __builtin_amdgcn_mfma_scale_f32_16x16x128_f8f6f4(cat8(Bt[n][0], Bt[n][1]), cat8(At[m][0], At[m][1]), acc[ai][bj][m][n], 0, 0, 0, 0, 0, 0);     __builtin_amdgcn_s_setprio(0); } while (0)
#define PG8_KLOOP(MMA, T0, T1, NT) \
        for (int t = T0; t < T1; t += 2) { \
            const bool last = (t == NT - 2); \
            const unsigned a1 = cA + (unsigned)(t + 1) * kstep; \
            const unsigned a2 = last ? nA : cA + (unsigned)(t + 2) * kstep; const unsigned b2 = last ? nB : cB + (unsigned)(t + 2) * kstep; \
            const unsigned a3 = a2 + kstep; const unsigned b3 = b2 + kstep; \
            if (last && has_next) S.a_ready(nxt); \
            PG8_LDB(B0, 0, 0); PG8_LDB(B1, 0, 1); PG8_SCHED; PG8_LDA(At, 0, 0); PG8_STAGE(PG8_SA(1, 1), a1 + hstep, voffA); \
            PG8_WAIT_V(8); PG8_WAIT_L(0); PG8_BAR; MMA(0, 0, At, B0); MMA(0, 1, At, B1); PG8_BAR; PG8_SCHED; \
            PG8_LDA(At, 0, 1); PG8_STAGE(PG8_SB(0, 0), b2, voffB); PG8_STAGE(PG8_SB(0, 1), b2 + hstep, voffB); PG8_STAGE(PG8_SA(0, 0), a2, voffA); \
            PG8_WAIT_V(8); PG8_WAIT_L(0); PG8_BAR; MMA(1, 0, At, B0); MMA(1, 1, At, B1); PG8_BAR; PG8_SCHED; \
            PG8_LDB(B0, 1, 0); PG8_LDB(B1, 1, 1); PG8_SCHED; PG8_LDA(At, 1, 0); PG8_STAGE(PG8_SA(0, 1), a2 + hstep, voffA); \
            PG8_WAIT_V(8); PG8_WAIT_L(0); PG8_BAR; MMA(0, 0, At, B0); MMA(0, 1, At, B1); PG8_BAR; PG8_SCHED; \
            PG8_LDA(At, 1, 1); PG8_STAGE(PG8_SB(1, 0), b3, voffB); PG8_STAGE(PG8_SB(1, 1), b3 + hstep, voffB); PG8_STAGE(PG8_SA(1, 0), a3, voffA); \
            PG8_WAIT_V(8); PG8_WAIT_L(0); PG8_BAR; MMA(1, 0, At, B0); MMA(1, 1, At, B1); PG8_BAR; PG8_SCHED; \
        }
    Unit cur, nxt; int ui = 0;
    if (!S.next(0, cur)) return;
    f32x4 acc[2][2][4][2];
#pragma unroll
    for (int a = 0; a < 2; ++a)
#pragma unroll
        for (int b = 0; b < 2; ++b)
#pragma unroll
            for (int m = 0; m < 4; ++m)
#pragma unroll
                for (int n = 0; n < 2; ++n) acc[a][b][m][n] = (f32x4){0.f, 0.f, 0.f, 0.f};
    bf16x8 At[4][2], B0[2][2], B1[2][2];
    unsigned cA = (cur.f8 ? g.A8 : g.A) + (unsigned)cur.pm * tstep, cB = g.Bt + (unsigned)cur.pn * tstep;
    S.a_ready(cur);
    if constexpr (SP2) {
        PG8_STAGE(PG8_SB(0, 0), cB, voffB); PG8_STAGE(PG8_SB(0, 1), cB + hstep, voffB); PG8_STAGE(PG8_SA(0, 0), cA, voffA); PG8_STAGE(PG8_SA(0, 1), cA + hstep, voffA);
        if (wr == 1) PG8_BAR;
        PG8_WAIT_V(2); PG8_BAR;
        PG8_STAGE(PG8_SB(1, 0), cB + kstep, voffB); PG8_STAGE(PG8_SA(1, 0), cA + kstep, voffA); PG8_STAGE(PG8_SB(1, 1), cB + hstep + kstep, voffB);
        PG8_WAIT_V(6); PG8_BAR;
    } else {
        PG8_STAGE(PG8_SB(0, 0), cB, voffB); PG8_STAGE(PG8_SA(0, 0), cA, voffA); PG8_STAGE(PG8_SB(0, 1), cB + hstep, voffB); PG8_STAGE(PG8_SA(0, 1), cA + hstep, voffA);
        if (wr == 1) PG8_BAR;
        PG8_WAIT_V(4); PG8_BAR;
        PG8_STAGE(PG8_SB(1, 0), cB + kstep, voffB); PG8_STAGE(PG8_SA(1, 0), cA + kstep, voffA); PG8_STAGE(PG8_SB(1, 1), cB + hstep + kstep, voffB);
        PG8_WAIT_V(6); PG8_BAR;
    }
    for (;;) {
        const bool has_next = S.next(ui + 1, nxt);
        const unsigned nA = has_next ? (nxt.f8 ? g.A8 : g.A) + (unsigned)nxt.pm * tstep : cA; const unsigned nB = has_next ? g.Bt + (unsigned)nxt.pn * tstep : cB;
        if constexpr (MIXK > 0) { PG8_KLOOP(PG8_MMA8, 0, MIXK, nt8) PG8_KLOOP(PG8_MMA, MIXK, nt8, nt8) }
        else { if (cur.f8) { PG8_KLOOP(PG8_MMA8, 0, nt8, nt8) } else { PG8_KLOOP(PG8_MMA, 0, nt, nt) } }
        if constexpr (ALIGN_EPI) { if (wr == 0) PG8_BAR; }
        if constexpr (!Epi::AFTER_DRAIN) { const int l_ = lane_now();
            E(acc, cur, wr, wc, l_ & 15, l_ >> 4); S.done(cur); }
        if (!has_next) break;
#pragma unroll
        for (int a = 0; a < 2; ++a)
#pragma unroll
            for (int b = 0; b < 2; ++b)
#pragma unroll
                for (int m = 0; m < 4; ++m)
#pragma unroll
                    for (int n = 0; n < 2; ++n) acc[a][b][m][n] = (f32x4){0.f, 0.f, 0.f, 0.f};
        cur = nxt; cA = nA; cB = nB; ++ui;
        if constexpr (ALIGN_EPI) { if (wr == 1) PG8_BAR; }
    }
    PG8_WAIT_V(0);
    if constexpr (!ALIGN_EPI) { if (wr == 0) PG8_BAR; }
    PG8_BAR;
    if constexpr (Epi::AFTER_DRAIN) { E.fused(acc, cur, wr, wc, fr, fq, lds, wid, lane); S.done(cur); }
#undef PG8_SA
#undef PG8_SB
#undef PG8_STAGE
#undef PG8_LDA
#undef PG8_LDB
#undef PG8_MMA
#undef PG8_MMA8
#undef PG8_KLOOP
#undef PG8_WAIT_V
#undef PG8_WAIT_L
#undef PG8_BAR
#undef PG8_SCHED
}
}
#define GAS __attribute__((address_space(1)))
#define LAS __attribute__((address_space(3)))
typedef unsigned short bf16;
typedef unsigned v4u __attribute__((ext_vector_type(4)));
typedef float f32x4 __attribute__((ext_vector_type(4)));
typedef short bf16x8 __attribute__((ext_vector_type(8)));
typedef GAS unsigned gu32;
typedef GAS unsigned long long gu64;
#define RLX_AGENT __ATOMIC_RELAXED, __HIP_MEMORY_SCOPE_AGENT
#define LDS_WAIT() asm volatile("s_waitcnt lgkmcnt(0)" ::: "memory")
#define VM_WAIT() asm volatile("s_waitcnt vmcnt(0)" ::: "memory")
__device__ __forceinline__ unsigned long long rt() { return __builtin_amdgcn_s_memrealtime(); }
__device__ __forceinline__ unsigned f2bf(float f) { unsigned u = __builtin_bit_cast(unsigned, f); return (u + 0x7fffu + ((u >> 16) & 1u)) >> 16; }
__device__ __forceinline__ unsigned pk2(float lo, float hi) { return f2bf(lo) | (f2bf(hi) << 16); }

#define XB_TMO      128
#define XB_XCNT(j)  (256  + 64 * (j))
#define XB_XSUB(j)  (1280 + 64 * (j))
#define XB_XGEN(j)  (2304 + 64 * (j))
#define XB_TOP      3328
#define XB_TOPGEN   3392
#define XCD_BAR_WORDS 3456
#define XB_SPIN_CAP (1u << 18)

__device__ __forceinline__ unsigned xb_ld(unsigned* p)              { return __hip_atomic_load(p, __ATOMIC_RELAXED, __HIP_MEMORY_SCOPE_AGENT); }
__device__ __forceinline__ unsigned xb_add(unsigned* p, unsigned v) { return __hip_atomic_fetch_add(p, v, __ATOMIC_RELAXED, __HIP_MEMORY_SCOPE_AGENT); }
__device__ __forceinline__ unsigned xb_xcc_id() { return (unsigned)__builtin_amdgcn_s_getreg((3 << 11) | 20) & 0xFu; }
#define XB_SPIN(cond, bar) do { unsigned _sp = 0; while (cond) { __builtin_amdgcn_s_sleep(1); \
    if ((++_sp & 255u) == 0u) { if (xb_ld(&(bar)[XB_TMO])) break; if (_sp > XB_SPIN_CAP) { atomicAdd(&(bar)[XB_TMO], 1u); break; } } } } while (0)

struct XcdBarrier {
    unsigned* bar; unsigned x; int wave;
    volatile LAS unsigned* st;
};

__device__ __forceinline__ XcdBarrier xcd_barrier_post(unsigned* bar, volatile LAS unsigned* st, int wave) {
    XcdBarrier b; b.bar = bar; b.x = xb_xcc_id(); b.st = st; b.wave = wave;
    if (wave == 0 && pg8::lane_now() == 0) (void)xb_add(&bar[XB_XCNT(b.x)], 1u);
    return b;
}
__device__ __forceinline__ void xcd_barrier_complete(unsigned* bar, unsigned x, unsigned& nloc, unsigned& nx) {
    const unsigned G = gridDim.x * gridDim.y * gridDim.z;
    unsigned sum, cnt, mine, sp = 0u;
    for (;;) {
        sum = 0u; cnt = 0u; mine = 0u;
#pragma unroll
        for (unsigned j = 0; j < 16; ++j) { const unsigned c = xb_ld(&bar[XB_XCNT(j)]); sum += c; cnt += (c > 0u) ? 1u : 0u; mine = (j == x) ? c : mine; }
        if (sum == G) break;
        __builtin_amdgcn_s_sleep(1);
        if ((++sp & 255u) == 0u) { if (xb_ld(&bar[XB_TMO])) break; if (sp > XB_SPIN_CAP) { atomicAdd(&bar[XB_TMO], 1u); break; } }
    }
    nloc = mine > 0u ? mine : 1u; nx = cnt > 0u ? cnt : 1u;
}

__device__ __forceinline__ void xcd_barrier(const XcdBarrier& b) {
    asm volatile("s_waitcnt vmcnt(0)" ::: "memory");
    __syncthreads();
    if (b.wave == 0 && pg8::lane_now() == 0) {
        unsigned* bar = b.bar;
        __builtin_amdgcn_s_waitcnt(0);
        unsigned nloc = b.st[0], nx = b.st[1];
        if (nloc == 0u) { xcd_barrier_complete(bar, b.x, nloc, nx); b.st[0] = nloc; b.st[1] = nx; }
        const unsigned old = xb_add(&bar[XB_XSUB(b.x)], 1u);
        const unsigned gen = old / nloc;
        if (old + 1u == (gen + 1u) * nloc) {
            __builtin_amdgcn_fence(__ATOMIC_RELEASE, "agent");
            asm volatile("s_waitcnt vmcnt(0)" ::: "memory");
            const unsigned og = xb_add(&bar[XB_TOP], 1u);
            const unsigned tg = og / nx;
            if (og + 1u == (tg + 1u) * nx) xb_add(&bar[XB_TOPGEN], 1u);
            else XB_SPIN(xb_ld(&bar[XB_TOPGEN]) == tg, bar);
            __builtin_amdgcn_fence(__ATOMIC_ACQUIRE, "agent");
            xb_add(&bar[XB_XGEN(b.x)], 1u);
            asm volatile("s_waitcnt vmcnt(0)" ::: "memory");
        } else {
            XB_SPIN(xb_ld(&bar[XB_XGEN(b.x)]) == gen, bar);
            __builtin_amdgcn_fence(__ATOMIC_ACQUIRE, "agent");
            asm volatile("s_waitcnt vmcnt(0)" ::: "memory");
        }
    }
    __syncthreads();
}
constexpr int NWAVES = 8;
constexpr int DM = 4096, SEQ = 4096, MROWS = 8192, MEMROWS = 512;
constexpr int INW = 11272;
constexpr int NPROJ = 11264;
constexpr int C_AQ = 0, C_AK = 2048, C_AV = 2560, C_AZ = 3072, C_MQ = 5120, C_MK = 5632, C_MV = 6144, C_MO = 7168, C_MZ = 8192, C_CQ = 9216, C_CZ = 10240;
constexpr float LN_EPS = 1e-5f, HEAD_NORM_EPS = 1e-6f;
constexpr float DEEPNORM_ALPHA = 1.189207115002721f;

constexpr size_t MiB = 1u << 20;
constexpr size_t WS_CTL = 0, CTL_ZERO_BYTES = 32768;
constexpr unsigned OPITCH = 8192 + 128;
constexpr size_t WS_ACAT = 2 * MiB;
constexpr size_t WS_BTCAT = 72 * MiB;
constexpr size_t WS_WOT = 178 * MiB;
constexpr size_t WS_PROJ = 210 * MiB;
constexpr size_t WS_MKV = 386 * MiB;
constexpr size_t WS_GATES = 388 * MiB;
constexpr size_t WS_MQK = 389 * MiB;
constexpr size_t WS_CLOC = 405 * MiB;
constexpr size_t WS_CPREV = 439 * MiB;
constexpr size_t WS_SMALL = 456 * MiB;
constexpr size_t WS_MIX = 457 * MiB;
constexpr size_t WS_Y = 521 * MiB;
constexpr size_t WS_A8 = 585 * MiB;
constexpr size_t WS_END = 656 * MiB;
constexpr int CW_BAR = 4096;
constexpr int CW_EARLY = 64, CW_LATE = 128  , CW_QHEAD = 192, CW_CLOCDONE = 256, CW_SCANDONE = 320;

constexpr int LDS_BYTES = 163840;
constexpr int MISC_OFF = LDS_BYTES - 256;

typedef unsigned v2u __attribute__((ext_vector_type(2)));
#define CAS __attribute__((address_space(4)))
struct Frame {
    LAS unsigned char* lds;
    volatile LAS unsigned* MISC;
    gu32* ctl;
    unsigned char* ws;
    const CAS unsigned char* kargs;
    int tid, lane, wave, G, vcu;
};
__device__ __forceinline__ const float* in_ptr(const Frame& F, int i) { const CAS unsigned char* p = F.kargs; asm volatile("" : "+s"(p)); return *(const float* const CAS*)(p + 8 * i); }
__device__ __forceinline__ float* out_ptr(const Frame& F) { const CAS unsigned char* p = F.kargs; asm volatile("" : "+s"(p)); return *(float* const CAS*)(p + 8 * 14); }
#define WSP(T, off) ((T*)(F.ws + (off)))
#ifdef PROBE_A
#define ISTAMP(k) do { __syncthreads(); if (F.tid == 0) F.MISC[20 + (k)] = (unsigned)__builtin_amdgcn_s_memrealtime(); __syncthreads(); } while (0)
#else
#define ISTAMP(k) do { } while (0)
#endif
__device__ __forceinline__ float bf2f(unsigned h) { return __builtin_bit_cast(float, h << 16); }
__device__ __forceinline__ unsigned pk4_f8(float a, float b, float c, float d) { int p = __builtin_amdgcn_cvt_pk_fp8_f32(a, b, 0, false); p = __builtin_amdgcn_cvt_pk_fp8_f32(c, d, p, true); return (unsigned)p; }
__device__ __forceinline__ float wave_sum(float v) {
#pragma unroll
    for (int o = 1; o < 64; o <<= 1) v += __shfl_xor(v, o);
    return v;
}
__device__ __forceinline__ float quad_max(float v) { v = fmaxf(v, __shfl_xor(v, 16)); v = fmaxf(v, __shfl_xor(v, 32)); return v; }
__device__ __forceinline__ float quad_sum(float v) { v += __shfl_xor(v, 16); v += __shfl_xor(v, 32); return v; }
__device__ __forceinline__ float row16_sum(float v) { v += __shfl_xor(v, 1); v += __shfl_xor(v, 2); v += __shfl_xor(v, 4); v += __shfl_xor(v, 8); return v; }
__device__ __forceinline__ float fast_exp(float v) { return __builtin_amdgcn_exp2f(1.4426950408889634f * v); }
__device__ __forceinline__ float sigmoidf_(float v) { return __builtin_amdgcn_rcpf(1.0f + fast_exp(-v)); }
__device__ __forceinline__ bf16x8 mk_frag(unsigned a, unsigned b, unsigned c, unsigned d) { v4u t; t.x = a; t.y = b; t.z = c; t.w = d; return __builtin_bit_cast(bf16x8, t); }
__device__ __forceinline__ bf16x8 ld_frag16(const LAS unsigned char* p) { return *(const LAS bf16x8*)p; }
__device__ __forceinline__ bf16x8 ld_frag8x2(const LAS unsigned char* p0, const LAS unsigned char* p1) {
    const v2u a = *(const LAS v2u*)p0, b = *(const LAS v2u*)p1; return mk_frag(a.x, a.y, b.x, b.y); }
#define MFMA16(a, b, c) __builtin_amdgcn_mfma_f32_16x16x32_bf16((a), (b), (c), 0, 0, 0)

__device__ __forceinline__ void stage_transposed(const bf16* src, size_t spitch, int nrows, int nch, LAS unsigned short* dst, int dpitch, const LAS float* rowscale, int tid) {
    for (int idx = tid; idx < nrows * nch; idx += NWAVES * 64) {
        const int row = idx & (nrows - 1), ch = idx / nrows;
        const v4u q = *(const GAS v4u*)(src + (size_t)row * spitch + ch * 8);
        unsigned e[8] = {q.x & 0xffffu, q.x >> 16, q.y & 0xffffu, q.y >> 16, q.z & 0xffffu, q.z >> 16, q.w & 0xffffu, q.w >> 16};
        LAS unsigned short* d = dst + (ch * 8) * dpitch + row;
        if (rowscale) { const float s = rowscale[row];
#pragma unroll
            for (int j = 0; j < 8; ++j) d[j * dpitch] = (unsigned short)f2bf(bf2f(e[j]) * s); }
        else {
#pragma unroll
            for (int j = 0; j < 8; ++j) d[j * dpitch] = (unsigned short)e[j]; }
    }
}

#ifndef P0_STORE_AUX
#define P0_STORE_AUX 16
#endif
__device__ __forceinline__ bool f8_row(int row) { const int t = row >> 8; return t >= 44 || ((pg8::F8_TILES >> t) & 1ull); }
__device__ __forceinline__ void p0_transpose_item(const float* W, int ldw, bf16* WT, int row_off, LAS float* scr, int kb, int nb, int lane, int q, unsigned kbyte, float wscale, unsigned rpitch = (unsigned)(DM * 2)) {
    const int k0 = 64 * kb, n0 = 32 * nb;
    {   const int r8 = lane >> 3, cq = lane & 7;
        f32x4 t[8];
#pragma unroll
        for (int i = 0; i < 8; ++i) t[i] = __builtin_nontemporal_load((const GAS f32x4*)(W + (size_t)(k0 + 8 * i + r8) * ldw + n0 + 4 * cq));
#pragma unroll
        for (int i = 0; i < 8; ++i) { LAS float* d = scr + (8 * i + r8) * 33 + 4 * cq; d[0] = t[i].x; d[1] = t[i].y; d[2] = t[i].z; d[3] = t[i].w; } }
    LDS_WAIT(); asm volatile("" ::: "memory");
    const int c = lane & 7;
    const __amdgpu_buffer_rsrc_t wrs = __builtin_amdgcn_make_buffer_rsrc(WT, 0, 0x7ffffff0u, 0x00020000);
#pragma unroll
    for (int j = 0; j < 4; ++j) { const int n = (lane >> 3) + 8 * j; const LAS float* s = scr + (8 * c) * 33 + n;
        if (q) { float e[8]; v2u hi;
#pragma unroll
            for (int i = 0; i < 8; ++i) e[i] = wscale * s[i * 33];
            const unsigned off = (unsigned)(row_off + n0 + n) * rpitch + kbyte + 8u * c;
            hi.x = pk4_f8(e[0], e[1], e[2], e[3]); hi.y = pk4_f8(e[4], e[5], e[6], e[7]);
            __builtin_amdgcn_raw_buffer_store_b64(hi, wrs, off, 0, P0_STORE_AUX); }
        else { v4u o; o.x = pk2(wscale * s[0 * 33], wscale * s[1 * 33]); o.y = pk2(wscale * s[2 * 33], wscale * s[3 * 33]); o.z = pk2(wscale * s[4 * 33], wscale * s[5 * 33]); o.w = pk2(wscale * s[6 * 33], wscale * s[7 * 33]);
            __builtin_amdgcn_raw_buffer_store_b128(o, wrs, (unsigned)(row_off + n0 + n) * rpitch + kbyte + 16u * c, 0, P0_STORE_AUX); } }
    LDS_WAIT(); asm volatile("" ::: "memory");
}
__device__ __forceinline__ void wout_item(Frame& F, int item) {
    const float* w_out = in_ptr(F, 11); bf16* WOT = WSP(bf16, WS_WOT);
    LAS float* scr = (LAS float*)(F.lds + F.wave * 16384);
    for (int j = 0; j < 8; ++j) { const int r = item * 64 + j * 8 + F.wave, kb = r / 128;
        const int q = (kb >= 32 && kb < 48) ? 0 : 1; const unsigned kbyte = kb < 32 ? 64u * kb : (kb < 48 ? 3072u + 128u * (kb - 32) : 2048u + 64u * (kb - 48));
        p0_transpose_item(w_out, DM, WOT, 0, scr, kb, r % 128, F.lane, q, kbyte, 512.f); }
    __syncthreads();
}
typedef __bf16 bf16x2_t __attribute__((ext_vector_type(2)));
__device__ __forceinline__ float dot2_bf16(unsigned w, unsigned x, float acc) { return __builtin_amdgcn_fdot2_f32_bf16(__builtin_bit_cast(bf16x2_t, w), __builtin_bit_cast(bf16x2_t, x), acc, false); }
__device__ __forceinline__ void p0_prologue(Frame& F) {
    const float* x = in_ptr(F, 0); const float* mem = in_ptr(F, 1); const float* w_in = in_ptr(F, 2); const float* b_i = in_ptr(F, 5); const float* b_f = in_ptr(F, 6); const float* w_mem_kv = in_ptr(F, 10); bf16* ACAT = WSP(bf16, WS_ACAT); bf16* BTCAT = WSP(bf16, WS_BTCAT); float* GATES = WSP(float, WS_GATES);
    const int gw = F.vcu * NWAVES + F.wave, NGW = F.G * NWAVES;
    LAS float* scr = (LAS float*)(F.lds + F.wave * 8448);
    LAS unsigned short* GW = (LAS unsigned short*)(F.lds + 67584);
    {   f32x4 ga[8], gb[8];
#pragma unroll
        for (int i = 0; i < 8; ++i) { const GAS f32x4* p = (const GAS f32x4*)(w_in + (size_t)(F.tid + 512 * i) * INW + 7168); ga[i] = p[0]; gb[i] = p[1]; }
#pragma unroll
        for (int i = 0; i < 8; ++i) { const int k = F.tid + 512 * i;
            GW[0 * DM + k] = (unsigned short)f2bf(ga[i].x); GW[1 * DM + k] = (unsigned short)f2bf(ga[i].y); GW[2 * DM + k] = (unsigned short)f2bf(ga[i].z); GW[3 * DM + k] = (unsigned short)f2bf(ga[i].w);
            GW[4 * DM + k] = (unsigned short)f2bf(gb[i].x); GW[5 * DM + k] = (unsigned short)f2bf(gb[i].y); GW[6 * DM + k] = (unsigned short)f2bf(gb[i].z); GW[7 * DM + k] = (unsigned short)f2bf(gb[i].w); } }
    __syncthreads();
    const float gate_bias = (F.lane < 4) ? b_i[F.lane] : ((F.lane < 8) ? b_f[F.lane - 4] : 0.f);
    constexpr int I0 = 64 * 224, I1 = 64 * 128, I2 = 64 * 64, NITEMS = I0 + I1 + I2;
    int it = gw;
#define P0_ITEMS(n) do { _Pragma("unroll 1") for (int c_ = 0; c_ < (n) && it < NITEMS; ++c_, it += NGW) { int r = it; \
        if (r < I0) { const bool q_ = f8_row(32 * (r % 224)); p0_transpose_item(w_in, INW, BTCAT, 0, scr, r / 224, r % 224, F.lane, q_ ? 1 : 0, (unsigned)(r / 224) * (q_ ? 64u : 128u), q_ ? 64.f : 1.f, OPITCH); } \
        else if ((r -= I0) < I1) { const bool q_ = f8_row(7168 + 32 * (r % 128)); p0_transpose_item(w_in + 7176, INW, BTCAT, 7168, scr, r / 128, r % 128, F.lane, q_ ? 1 : 0, (unsigned)(r / 128) * (q_ ? 64u : 128u), q_ ? 64.f : 1.f, OPITCH); } \
        else { r -= I1; p0_transpose_item(w_mem_kv, 2048, BTCAT, 11264, scr, r / 64, r % 64, F.lane, 1, (unsigned)(r / 64) * 64u, 64.f, OPITCH); } } } while (0)
#pragma unroll 1
    for (int m = gw; m < MROWS + MEMROWS; m += NGW) {
        const bool isx = m < MROWS;
        const GAS f32x4* xr = (const GAS f32x4*)((isx ? x : mem) + (size_t)(isx ? m : m - MROWS) * DM) + F.lane;
        f32x4 v[16];
#pragma unroll
        for (int j = 0; j < 16; ++j) v[j] = __builtin_nontemporal_load(xr + 64 * j);
        P0_ITEMS(3);
        GAS v2u* o8 = (GAS v2u*)(ACAT + (size_t)m * DM) + F.lane;
        v2u xp[16];
        const __amdgpu_buffer_rsrc_t xrs = __builtin_amdgcn_make_buffer_rsrc(F.ws, 0, (unsigned)WS_END, 0x00020000);
        const unsigned xo_ = (unsigned)WS_ACAT + (unsigned)m * OPITCH + 8u * F.lane, xo8_ = (unsigned)WS_A8 + (unsigned)m * OPITCH + 4u * F.lane;
#pragma unroll
        for (int j = 0; j < 16; ++j) { xp[j].x = pk2(v[j].x, v[j].y); xp[j].y = pk2(v[j].z, v[j].w); __builtin_amdgcn_raw_buffer_store_b64(xp[j], xrs, xo_ + 512u * j, 0, P0_STORE_AUX); }
        {   GAS unsigned* o8f = (GAS unsigned*)(F.ws + WS_A8 + (size_t)m * (DM * 2)) + F.lane;
#pragma unroll
            for (int j = 0; j < 16; ++j) __builtin_amdgcn_raw_buffer_store_b32(pk4_f8(v[j].x, v[j].y, v[j].z, v[j].w), xrs, xo8_ + 256u * j, 0, P0_STORE_AUX); }
        if (isx) {
            float res = 0.f;
#pragma unroll 1
            for (int g = 0; g < 8; ++g) { float a0 = 0.f, a1 = 0.f;
#pragma unroll
                for (int j = 0; j < 16; ++j) { const v2u w = *(const LAS v2u*)(GW + g * DM + 256 * j + 4 * F.lane); a0 = dot2_bf16(w.x, xp[j].x, a0); a1 = dot2_bf16(w.y, xp[j].y, a1); }
                a0 = wave_sum(a0 + a1); res = (F.lane == g) ? a0 : res; }
            if (F.lane < 8) GATES[(size_t)m * 8 + F.lane] = res + gate_bias;
        }
    }
    P0_ITEMS(1 << 30);
#undef P0_ITEMS
}

__device__ __forceinline__ float log_sigmoid_f(float v) { return fminf(v, 0.f) - log1pf(expf(-fabsf(v))); }
template <int OP> __device__ __forceinline__ void wave_scan128(const LAS float* in, LAS float* out, int lane) {
    const float e0 = in[2 * lane], e1 = in[2 * lane + 1];
    float s = OP ? fmaxf(e0, e1) : (e0 + e1);
#pragma unroll
    for (int o = 1; o < 64; o <<= 1) { const float t = __shfl_up(s, o); if (lane >= o) s = OP ? fmaxf(s, t) : (s + t); }
    float ex = __shfl_up(s, 1);
    if (OP) { const float a = (lane == 0) ? e0 : fmaxf(ex, e0); out[2 * lane] = a; out[2 * lane + 1] = fmaxf(a, e1); }
    else { const float a = (lane == 0) ? e0 : (ex + e0); out[2 * lane] = a; out[2 * lane + 1] = a + e1; }
}

typedef short s16x4 __attribute__((ext_vector_type(4)));
__device__ __forceinline__ s16x4 ds_tr(const LAS unsigned char* p) { return __builtin_bit_cast(s16x4, __builtin_amdgcn_ds_read_tr16_b64_v4i16((LAS s16x4*)p)); }
__device__ __forceinline__ bf16x8 tr_frag(const LAS unsigned char* p0, const LAS unsigned char* p1) { const s16x4 a = ds_tr(p0), b = ds_tr(p1); return __builtin_shufflevector(a, b, 0, 1, 2, 3, 4, 5, 6, 7); }
__device__ __forceinline__ v4u ldg16(const bf16* p) { return *(const GAS v4u*)p; }
__device__ __forceinline__ void stg16(bf16* p, v4u v) { *(GAS v4u*)p = v; }
__device__ __forceinline__ void ws_store16_sc1(const Frame& F, size_t off, v4u v) {
    const __amdgpu_buffer_rsrc_t rsrc = __builtin_amdgcn_make_buffer_rsrc(F.ws, 0, (unsigned)WS_END, 0x00020000);
    __builtin_amdgcn_raw_buffer_store_b128(v, rsrc, (unsigned)off, 0, 16); }
__device__ __forceinline__ v4u zero4() { v4u z; z.x = 0u; z.y = 0u; z.z = 0u; z.w = 0u; return z; }
__device__ __forceinline__ v2u gate_pack8(f32x4 a, f32x4 b, float s, v4u z) {
    const float t = 8.f * s; v2u o;
    o.x = pk4_f8(a[0] * t * bf2f(z.x & 0xffffu), a[1] * t * bf2f(z.x >> 16), a[2] * t * bf2f(z.y & 0xffffu), a[3] * t * bf2f(z.y >> 16));
    o.y = pk4_f8(b[0] * t * bf2f(z.z & 0xffffu), b[1] * t * bf2f(z.z >> 16), b[2] * t * bf2f(z.w & 0xffffu), b[3] * t * bf2f(z.w >> 16));
    return o; }
__device__ __forceinline__ void stg8(unsigned char* p, v2u v) { *(GAS v2u*)p = v; }
__device__ __forceinline__ v4u gate_pack(f32x4 a, f32x4 b, float s, v4u z) {
    v4u o;
    o.x = pg8::cvt_pk_bf16(a[0] * s * bf2f(z.x & 0xffffu), a[1] * s * bf2f(z.x >> 16)); o.y = pg8::cvt_pk_bf16(a[2] * s * bf2f(z.y & 0xffffu), a[3] * s * bf2f(z.y >> 16));
    o.z = pg8::cvt_pk_bf16(b[0] * s * bf2f(z.z & 0xffffu), b[1] * s * bf2f(z.z >> 16)); o.w = pg8::cvt_pk_bf16(b[2] * s * bf2f(z.w & 0xffffu), b[3] * s * bf2f(z.w >> 16));
    return o;
}

__device__ __forceinline__ void scan_item(Frame& F, int sl) {
    float* CLOC = WSP(float, WS_CLOC); float* CST = WSP(float, WS_SMALL); float* MPREV = WSP(float, WS_SMALL + 4096);
    const int gt = sl * (NWAVES * 64) + F.tid;
    constexpr int OCT = 257 * 16;
    if (gt < 8 * OCT) {
        const int bh = gt / OCT, off = (gt % OCT) * 8;
        float m = 0.f; f32x4 c0 = {0.f, 0.f, 0.f, 0.f}, c1 = {0.f, 0.f, 0.f, 0.f};
#pragma unroll 8
        for (int c = 0; c < 32; ++c) {
            const int item = bh * 32 + c;
            const float gl = CST[item * 2], ml = CST[item * 2 + 1];
            const GAS f32x4* cp = (const GAS f32x4*)(CLOC + (size_t)item * (257 * 128) + off);
            const f32x4 cl0 = cp[0], cl1 = cp[1];
            v4u o; o.x = pk2(c0[0], c0[1]); o.y = pk2(c0[2], c0[3]); o.z = pk2(c1[0], c1[1]); o.w = pk2(c1[2], c1[3]);
            ws_store16_sc1(F, WS_CPREV + ((size_t)item * (257 * 128) + off) * 2, o);
            if (off == 0) __hip_atomic_store(MPREV + item, m, RLX_AGENT);
            const float mn = fmaxf(gl + m, ml), sp = expf(gl + m - mn), sl2 = expf(ml - mn);
            c0 = c0 * sp + cl0 * sl2; c1 = c1 * sp + cl1 * sl2; m = mn;
        }
    }
    asm volatile("s_waitcnt vmcnt(0)" ::: "memory");
    __syncthreads();
    if (F.tid == 0) __hip_atomic_fetch_add(F.ctl + CW_SCANDONE, 1u, RLX_AGENT);
}

__device__ __forceinline__ void swa_item4(Frame& F, int item) {
    int tid = F.tid; asm volatile("" : "+v"(tid)); const int lane = tid & 63;
    const float* rel_bias = in_ptr(F, 8); const float* sinks = in_ptr(F, 9); bf16* PROJ = WSP(bf16, WS_PROJ); bf16* MIX = WSP(bf16, WS_MIX);
    const int b = item >> 7, n = (item >> 2) & 31, kv = item & 3;
    const int row0 = b * SEQ + n * 128;
    LAS unsigned char* Ks = F.lds;
    LAS unsigned char* Vs = F.lds + 69632;
    LAS float* BT = (LAS float*)(F.lds + 143360);
    const int g = F.wave >> 1, head = kv * 4 + g, l15 = lane & 15, quad = lane >> 4, tq = (lane & 15) >> 2, tp = lane & 3;
    const int qw = (F.wave & 1) * 64;
    bf16x8 qf[2][2][4];
#pragma unroll
    for (int ds = 0; ds < 2; ++ds)
#pragma unroll
        for (int qt = 0; qt < 2; ++qt) { const bf16* qp = PROJ + (size_t)(row0 + qw + 32 * ds + 16 * qt + l15) * NPROJ + C_AQ + head * 128 + 8 * quad;
#pragma unroll
            for (int ks = 0; ks < 4; ++ks) qf[ds][qt][ks] = __builtin_bit_cast(bf16x8, ldg16(qp + 32 * ks)); }
    {   const int gg = tid >> 7, dist = tid & 127; int bucket = dist;
        if (dist >= 16) { const float ratio = (float)dist / 16.0f; const int lg = 16 + (int)(logf(ratio) / logf(8.0f) * 16.0f); bucket = lg < 31 ? lg : 31; }
        BT[gg * 128 + dist] = rel_bias[bucket * 16 + kv * 4 + gg] * 1.4426950408889634f; }
    {   v4u kq[8], vq[8];
#pragma unroll
        for (int it = 0; it < 8; ++it) { const int idx = tid + 512 * it, key = idx >> 4, ch = idx & 15; const bool valid = (n > 0) || (key >= 128);
            kq[it] = zero4(); vq[it] = zero4();
            if (valid) { const bf16* src = PROJ + (size_t)(row0 - 128 + key) * NPROJ + kv * 128 + ch * 8; kq[it] = ldg16(src + C_AK); vq[it] = ldg16(src + C_AV); } }
#pragma unroll
        for (int it = 0; it < 8; ++it) { const int idx = tid + 512 * it, key = idx >> 4, ch = idx & 15;
            *(LAS v4u*)(Ks + key * 272 + ch * 16) = kq[it]; *(LAS v4u*)(Vs + key * 288 + ch * 16) = vq[it]; } }
    __syncthreads();
    ISTAMP(26);
    const float sink = sinks[head];
    const float scale = 0.08838834764831845f;
#pragma unroll
    for (int ds = 0; ds < 2; ++ds) {
        const int q0 = qw + 32 * ds, kbase = q0;
        v4u zz[2][4];
#pragma unroll
        for (int qt = 0; qt < 2; ++qt) { const bf16* zp = PROJ + (size_t)(row0 + q0 + 16 * qt + l15) * NPROJ + C_AZ + head * 128 + 8 * quad;
#pragma unroll
            for (int P2 = 0; P2 < 4; ++P2) zz[qt][P2] = ldg16(zp + 32 * P2); }
        f32x4 st[2][10];
#pragma unroll
        for (int kt = 0; kt < 10; ++kt) { f32x4 a0 = {0.f, 0.f, 0.f, 0.f}, a1 = {0.f, 0.f, 0.f, 0.f}; const LAS unsigned char* kp = Ks + (kbase + 16 * kt + l15) * 272 + 16 * quad;
#pragma unroll
            for (int ks = 0; ks < 4; ++ks) { const bf16x8 kf = ld_frag16(kp + 64 * ks); a0 = MFMA16(kf, qf[ds][0][ks], a0); a1 = MFMA16(kf, qf[ds][1][ks], a1); }
            st[0][kt] = a0; st[1][kt] = a1; }
        if (ds == 0) ISTAMP(27);
        bf16x8 pb[2][5]; float inv[2];
        const float sc2 = scale * 1.4426950408889634f, sink2 = sink * 1.4426950408889634f;
        const LAS float* btl = BT + g * 128 + l15 - 4 * quad;
#pragma unroll
        for (int qt = 0; qt < 2; ++qt) {
            float mx = sink2;
            if (n > 0) {
#pragma unroll
                for (int kt = 0; kt < 10; ++kt) { const int delta = kt - qt;
                    if (delta < 0 || delta > 8) { st[qt][kt] = (f32x4){-INFINITY, -INFINITY, -INFINITY, -INFINITY}; continue; }
#pragma unroll
                    for (int r = 0; r < 4; ++r) { const int e = l15 - 4 * quad - r;
                        float sv = st[qt][kt][r] * sc2 + btl[128 - 16 * delta - r];
                        if (delta == 0) sv = (e < 0) ? sv : -INFINITY;
                        if (delta == 8) sv = (e >= 0) ? sv : -INFINITY;
                        st[qt][kt][r] = sv; mx = fmaxf(mx, sv); } }
            } else {
                const int qi = q0 + 16 * qt + l15;
#pragma unroll
                for (int kt = 0; kt < 10; ++kt)
#pragma unroll
                    for (int r = 0; r < 4; ++r) { const int si = kbase + 16 * kt + 4 * quad + r, dist = qi + 128 - si;
                        const bool ok = (dist >= 0) && (dist < 128) && (si >= 128);
                        const float sv = ok ? st[qt][kt][r] * sc2 + BT[g * 128 + (dist & 127)] : -INFINITY;
                        st[qt][kt][r] = sv; mx = fmaxf(mx, sv); }
            }
            mx = quad_max(mx);
            float sum = 0.f;
#pragma unroll
            for (int kt = 0; kt < 10; ++kt)
#pragma unroll
                for (int r = 0; r < 4; ++r) { const float p = __builtin_amdgcn_exp2f(st[qt][kt][r] - mx); st[qt][kt][r] = p; sum += p; }
            sum = quad_sum(sum) + __builtin_amdgcn_exp2f(sink2 - mx);
            inv[qt] = 1.0f / sum;
#pragma unroll
            for (int kp = 0; kp < 5; ++kp) { const f32x4 p0 = st[qt][2 * kp], p1 = st[qt][2 * kp + 1];
                pb[qt][kp] = mk_frag(pg8::cvt_pk_bf16(p0[0], p0[1]), pg8::cvt_pk_bf16(p0[2], p0[3]), pg8::cvt_pk_bf16(p1[0], p1[1]), pg8::cvt_pk_bf16(p1[2], p1[3])); }
        }
        if (ds == 0) ISTAMP(28);
        const LAS unsigned char* vb = Vs + (kbase + 4 * quad + tq) * 288 + 16 * tp;
#pragma unroll
        for (int P2 = 0; P2 < 4; ++P2) {
            f32x4 o00 = {0.f, 0.f, 0.f, 0.f}, o01 = o00, o10 = o00, o11 = o00;
#pragma unroll
            for (int kp = 0; kp < 5; ++kp) { const LAS unsigned char* va = vb + (32 * kp) * 288 + 64 * P2;
                const bf16x8 v0 = tr_frag(va, va + 16 * 288), v1 = tr_frag(va + 8, va + 16 * 288 + 8);
                o00 = MFMA16(v0, pb[0][kp], o00); o01 = MFMA16(v1, pb[0][kp], o01);
                o10 = MFMA16(v0, pb[1][kp], o10); o11 = MFMA16(v1, pb[1][kp], o11); }
            unsigned char* op = (unsigned char*)(MIX + (size_t)(row0 + q0 + l15) * DM) + head * 128 + 8 * quad + 32 * P2;
            stg8(op, gate_pack8(o00, o01, inv[0], zz[0][P2]));
            stg8(op + (size_t)16 * DM * 2, gate_pack8(o10, o11, inv[1], zz[1][P2]));
        }
    }
    __syncthreads();
}

__device__ __forceinline__ void cross_item3(Frame& F, int item) {
    int tid = F.tid; asm volatile("" : "+v"(tid)); const int lane = tid & 63;
    bf16* PROJ = WSP(bf16, WS_PROJ); bf16* MKV = WSP(bf16, WS_MKV); bf16* MIX = WSP(bf16, WS_MIX);
    const int b = item >> 7, h = (item >> 5) & 3, qt = item & 31;
    const int l15 = lane & 15, quad = lane >> 4, tq = (lane & 15) >> 2, tp = lane & 3;
    const size_t grow = (size_t)b * SEQ + qt * 128 + F.wave * 16 + l15;
    const bf16* kvsrc = MKV + (size_t)(b * 256) * 2048 + h * 256;
    bf16x8 qf[8];
    { const bf16* qp = PROJ + grow * NPROJ + C_CQ + h * 256 + 8 * quad;
#pragma unroll
      for (int ks = 0; ks < 8; ++ks) qf[ks] = __builtin_bit_cast(bf16x8, ldg16(qp + 32 * ks)); }
    {   v4u t[16];
#pragma unroll
        for (int it = 0; it < 16; ++it) { const int idx = tid + 512 * it, m = idx >> 5, ch = idx & 31; t[it] = ldg16(kvsrc + (size_t)m * 2048 + ch * 8); }
#pragma unroll
        for (int it = 0; it < 16; ++it) { const int idx = tid + 512 * it, m = idx >> 5, ch = idx & 31; *(LAS v4u*)(F.lds + m * 528 + ch * 16) = t[it]; } }
    __syncthreads();
    v4u vt[16];
#pragma unroll
    for (int it = 0; it < 16; ++it) { const int idx = tid + 512 * it, m = idx >> 5, ch = idx & 31; vt[it] = ldg16(kvsrc + 1024 + (size_t)m * 2048 + ch * 8); }
    bf16x8 pb[8]; float inv;
    {
        f32x4 st[16];
#pragma unroll
        for (int kt = 0; kt < 16; ++kt) { f32x4 a = {0.f, 0.f, 0.f, 0.f}; const LAS unsigned char* kp = F.lds + (16 * kt + l15) * 528 + 16 * quad;
#pragma unroll
            for (int ks = 0; ks < 8; ++ks) a = MFMA16(ld_frag16(kp + 64 * ks), qf[ks], a);
            st[kt] = a; }
        float mx = -INFINITY;
#pragma unroll
        for (int kt = 0; kt < 16; ++kt)
#pragma unroll
            for (int r = 0; r < 4; ++r) { const float sc = st[kt][r] * 0.0625f; st[kt][r] = sc; mx = fmaxf(mx, sc); }
        mx = quad_max(mx);
        float sum = 0.f;
#pragma unroll
        for (int kt = 0; kt < 16; ++kt)
#pragma unroll
            for (int r = 0; r < 4; ++r) { const float p = fast_exp(st[kt][r] - mx); st[kt][r] = p; sum += p; }
        sum = quad_sum(sum);
        inv = 1.0f / sum;
#pragma unroll
        for (int kp = 0; kp < 8; ++kp) { const f32x4 p0 = st[2 * kp], p1 = st[2 * kp + 1];
            pb[kp] = mk_frag(pg8::cvt_pk_bf16(p0[0], p0[1]), pg8::cvt_pk_bf16(p0[2], p0[3]), pg8::cvt_pk_bf16(p1[0], p1[1]), pg8::cvt_pk_bf16(p1[2], p1[3])); }
    }
    __syncthreads();
#pragma unroll
    for (int it = 0; it < 16; ++it) { const int idx = tid + 512 * it, m = idx >> 5, ch = idx & 31; *(LAS v4u*)(F.lds + m * 544 + ch * 16) = vt[it]; }
    const bf16* zp = PROJ + grow * NPROJ + C_CZ + h * 256 + 8 * quad; unsigned char* op = (unsigned char*)(MIX + grow * DM) + 2048 + h * 256 + 8 * quad;
    v4u zz[8];
#pragma unroll
    for (int P2 = 0; P2 < 8; ++P2) zz[P2] = ldg16(zp + 32 * P2);
    __syncthreads();
    const LAS unsigned char* vb = F.lds + (4 * quad + tq) * 544 + 16 * tp;
#pragma unroll
    for (int P2 = 0; P2 < 8; ++P2) {
        f32x4 o0 = {0.f, 0.f, 0.f, 0.f}, o1 = {0.f, 0.f, 0.f, 0.f};
#pragma unroll
        for (int kp = 0; kp < 8; ++kp) { const LAS unsigned char* va = vb + (32 * kp) * 544 + 64 * P2;
            o0 = MFMA16(tr_frag(va, va + 16 * 544), pb[kp], o0);
            o1 = MFMA16(tr_frag(va + 8, va + 16 * 544 + 8), pb[kp], o1); }
        stg8(op + 32 * P2, gate_pack8(o0, o1, inv, zz[P2]));
    }
    __syncthreads();
}

__device__ __forceinline__ void conv8(const v4u (&r)[4], const f32x4 (&w)[4][2], const f32x4 (&cb)[2], float oscale, v4u& o) {
    float y[8];
#pragma unroll
    for (int e = 0; e < 8; ++e) y[e] = cb[e >> 2][e & 3];
#pragma unroll
    for (int j = 0; j < 4; ++j) { const unsigned q[4] = {r[j].x, r[j].y, r[j].z, r[j].w};
#pragma unroll
        for (int e = 0; e < 8; ++e) { const float xv = (e & 1) ? bf2f(q[e >> 1] >> 16) : bf2f(q[e >> 1] & 0xffffu); y[e] += w[j][e >> 2][e & 3] * xv; } }
#pragma unroll
    for (int e = 0; e < 8; ++e) y[e] = y[e] * sigmoidf_(y[e]) * oscale;
    o.x = pk2(y[0], y[1]); o.y = pk2(y[2], y[3]); o.z = pk2(y[4], y[5]); o.w = pk2(y[6], y[7]);
}
__device__ __forceinline__ void cloc_item3(Frame& F, int item) {
    int tid = F.tid; asm volatile("" : "+v"(tid)); const int lane = tid & 63;
    const float* conv_w = in_ptr(F, 3); const float* conv_b = in_ptr(F, 4); bf16* PROJ = WSP(bf16, WS_PROJ); float* GATES = WSP(float, WS_GATES); float* CST = WSP(float, WS_SMALL);
    const int b = item >> 7, h = (item >> 5) & 3, c = item & 31;
    const int r0 = b * SEQ + c * 128;
    LAS unsigned char* V = F.lds; LAS unsigned char* KQ = F.lds + 69632;
    LAS float* LI = (LAS float*)(F.lds + 106496); LAS float* LF = LI + 128; LAS float* BB = LF + 128; LAS float* WW = BB + 128;
    {   v4u vt[8];
#pragma unroll
        for (int it = 0; it < 8; ++it) { const int idx = tid + 512 * it, l = idx >> 5, ch = idx & 31; vt[it] = ldg16(PROJ + (size_t)(r0 + l) * NPROJ + C_MV + h * 256 + ch * 8); }
        float li = 0.f, fp = 0.f;
        if (tid < 128) { li = GATES[(size_t)(r0 + tid) * 8 + h]; fp = GATES[(size_t)(r0 + tid) * 8 + 4 + h]; }
#pragma unroll
        for (int it = 0; it < 8; ++it) { const int idx = tid + 512 * it, l = idx >> 5, ch = idx & 31; *(LAS v4u*)(V + l * 544 + ch * 16) = vt[it]; }
        if (tid < 128) { v4u o1 = zero4(); o1.x = 0x3F80u; *(LAS v4u*)(V + tid * 544 + 512) = o1; *(LAS v4u*)(V + tid * 544 + 528) = zero4(); LI[tid] = li; LF[tid] = log_sigmoid_f(fp); }
    }
    __syncthreads();
    if (F.wave == 0) {
        wave_scan128<0>(LF, BB, lane);
        const float gl = __shfl(BB[2 * lane + 1], 63);
        const float a0 = gl - BB[2 * lane] + LI[2 * lane], a1 = gl - BB[2 * lane + 1] + LI[2 * lane + 1];
        float mx = fmaxf(a0, a1);
#pragma unroll
        for (int o = 1; o < 64; o <<= 1) mx = fmaxf(mx, __shfl_xor(mx, o));
        WW[2 * lane] = expf(a0 - mx); WW[2 * lane + 1] = expf(a1 - mx);
        if (lane == 0) { __hip_atomic_store(CST + item * 2, gl, RLX_AGENT); __hip_atomic_store(CST + item * 2 + 1, mx, RLX_AGENT); }
    }
    v4u kpk[4];
    {   const int ch = tid & 15;
        f32x4 wq[4][2], wk[4][2], bq[2], bk[2];
#pragma unroll
        for (int j = 0; j < 4; ++j) { const GAS f32x4* pq = (const GAS f32x4*)(conv_w + j * 1024 + h * 128 + ch * 8); const GAS f32x4* pk = (const GAS f32x4*)(conv_w + j * 1024 + 512 + h * 128 + ch * 8);
            wq[j][0] = pq[0]; wq[j][1] = pq[1]; wk[j][0] = pk[0]; wk[j][1] = pk[1]; }
        { const GAS f32x4* pq = (const GAS f32x4*)(conv_b + h * 128 + ch * 8); const GAS f32x4* pk = (const GAS f32x4*)(conv_b + 512 + h * 128 + ch * 8); bq[0] = pq[0]; bq[1] = pq[1]; bk[0] = pk[0]; bk[1] = pk[1]; }
#pragma unroll
        for (int i = 0; i < 4; ++i) { const int l = (tid >> 4) + 32 * i;
            v4u rq[4], rk[4];
#pragma unroll
            for (int j = 0; j < 4; ++j) { const int rr = l - 3 + j; rq[j] = zero4(); rk[j] = zero4();
                if (c > 0 || rr >= 0) { const bf16* src = PROJ + (size_t)(r0 + rr) * NPROJ + h * 128 + ch * 8; rq[j] = ldg16(src + C_MQ); rk[j] = ldg16(src + C_MK); } }
            v4u oq; conv8(rq, wq, bq, 1.0f, oq); conv8(rk, wk, bk, 0.08838834764831845f, kpk[i]);
            ws_store16_sc1(F, WS_MQK + ((size_t)(r0 + l) * 1024 + h * 128 + ch * 8) * 2, oq);
            ws_store16_sc1(F, WS_MQK + ((size_t)(r0 + l) * 1024 + 512 + h * 128 + ch * 8) * 2, kpk[i]); }
    }
    __syncthreads();
    {   const int ch = tid & 15;
#pragma unroll
        for (int i = 0; i < 4; ++i) { const int l = (tid >> 4) + 32 * i; const float w = WW[l]; const v4u k = kpk[i]; v4u o;
            o.x = pk2(bf2f(k.x & 0xffffu) * w, bf2f(k.x >> 16) * w); o.y = pk2(bf2f(k.y & 0xffffu) * w, bf2f(k.y >> 16) * w);
            o.z = pk2(bf2f(k.z & 0xffffu) * w, bf2f(k.z >> 16) * w); o.w = pk2(bf2f(k.w & 0xffffu) * w, bf2f(k.w >> 16) * w);
            *(LAS v4u*)(KQ + l * 288 + ch * 16) = o; } }
    __syncthreads();
    {   const int l15 = lane & 15, quad = lane >> 4, tq = (lane & 15) >> 2, tp = lane & 3;
        const LAS unsigned char* kb = KQ + (8 * quad + tq) * 288 + 8 * tp;
        const LAS unsigned char* vb = V + (8 * quad + tq) * 544 + 8 * tp;
        for (int vt = F.wave; vt < 17; vt += 8) {
            bf16x8 bfr[4];
#pragma unroll
            for (int ks = 0; ks < 4; ++ks) { const LAS unsigned char* p = vb + (32 * ks) * 544 + 32 * vt; bfr[ks] = tr_frag(p, p + 4 * 544); }
            const int v = 16 * vt + l15;
#pragma unroll
            for (int nt = 0; nt < 8; ++nt) { f32x4 a = {0.f, 0.f, 0.f, 0.f};
#pragma unroll
                for (int ks = 0; ks < 4; ++ks) { const LAS unsigned char* p = kb + (32 * ks) * 288 + 32 * nt; a = MFMA16(tr_frag(p, p + 4 * 288), bfr[ks], a); }
                if (v < 257) ws_store16_sc1(F, WS_CLOC + ((size_t)item * (257 * 128) + (size_t)v * 128 + 16 * nt + 4 * quad) * 4, __builtin_bit_cast(v4u, a)); }
        }
    }
    asm volatile("s_waitcnt vmcnt(0)" ::: "memory");
    __syncthreads();
    if (tid == 0) __hip_atomic_fetch_add(F.ctl + CW_CLOCDONE, 1u, RLX_AGENT);
}

__device__ __forceinline__ void mout_item3(Frame& F, int item) {
    int tid = F.tid; asm volatile("" : "+v"(tid)); const int lane = tid & 63;
    const float* m_norm_g = in_ptr(F, 7); bf16* PROJ = WSP(bf16, WS_PROJ); bf16* MQK = WSP(bf16, WS_MQK); bf16* CPREV = WSP(bf16, WS_CPREV); float* GATES = WSP(float, WS_GATES); float* MPREV = WSP(float, WS_SMALL + 4096); bf16* MIX = WSP(bf16, WS_MIX);
    const int b = item >> 7, h = (item >> 5) & 3, c = item & 31;
    const int r0 = b * SEQ + c * 128;
    LAS unsigned char* V = F.lds; LAS unsigned char* CP = F.lds + 69632;
    LAS float* LI = (LAS float*)(F.lds + 143616); LAS float* LF = LI + 128; LAS float* BB = LF + 128; LAS float* UU = BB + 128; LAS float* MM = UU + 128;
    const float mprev = MPREV[item];
    {   v4u vt[8], ct[9];
#pragma unroll
        for (int it = 0; it < 8; ++it) { const int idx = tid + 512 * it, l = idx >> 5, ch = idx & 31; vt[it] = ldg16(PROJ + (size_t)(r0 + l) * NPROJ + C_MV + h * 256 + ch * 8); }
#pragma unroll
        for (int it = 0; it < 9; ++it) { const int idx = tid + 512 * it, row = idx >> 4, ch = idx & 15; ct[it] = zero4();
            if (row < 257) ct[it] = ldg16(CPREV + (size_t)item * (257 * 128) + row * 128 + ch * 8); }
        float li = 0.f, fp = 0.f;
        if (tid < 128) { li = GATES[(size_t)(r0 + tid) * 8 + h]; fp = GATES[(size_t)(r0 + tid) * 8 + 4 + h]; }
#pragma unroll
        for (int it = 0; it < 8; ++it) { const int idx = tid + 512 * it, l = idx >> 5, ch = idx & 31; *(LAS v4u*)(V + l * 544 + ch * 16) = vt[it]; }
#pragma unroll
        for (int it = 0; it < 9; ++it) { const int idx = tid + 512 * it, row = idx >> 4, ch = idx & 15; if (row < 272) *(LAS v4u*)(CP + row * 272 + ch * 16) = ct[it]; }
        if (tid < 128) { v4u o1 = zero4(); o1.x = 0x3F80u; *(LAS v4u*)(V + tid * 544 + 512) = o1; *(LAS v4u*)(V + tid * 544 + 528) = zero4(); LI[tid] = li; LF[tid] = log_sigmoid_f(fp); }
    }
    __syncthreads();
    const int l15 = lane & 15, quad = lane >> 4, tq = (lane & 15) >> 2, tp = lane & 3, t0 = 16 * F.wave;
    const int t = t0 + l15;
    const size_t grow = (size_t)(r0 + t);
    bf16x8 qf[4], kf[8][4];
    { const bf16* qp = MQK + grow * 1024 + h * 128 + 8 * quad;
#pragma unroll
      for (int ks = 0; ks < 4; ++ks) qf[ks] = __builtin_bit_cast(bf16x8, ldg16(qp + 32 * ks)); }
#pragma unroll
    for (int st = 0; st < 8; ++st) { const bf16* kp = MQK + (size_t)(r0 + 16 * st + l15) * 1024 + 512 + h * 128 + 8 * quad;
#pragma unroll
        for (int ks = 0; ks < 4; ++ks) kf[st][ks] = __builtin_bit_cast(bf16x8, ldg16(kp + 32 * ks)); }
    if (F.wave == 0) {
        wave_scan128<0>(LF, BB, lane);
        UU[2 * lane] = LI[2 * lane] - BB[2 * lane]; UU[2 * lane + 1] = LI[2 * lane + 1] - BB[2 * lane + 1];
        wave_scan128<1>(UU, MM, lane);
        MM[2 * lane] = fmaxf(MM[2 * lane], mprev); MM[2 * lane + 1] = fmaxf(MM[2 * lane + 1], mprev);
    }
    __syncthreads();
    const float Mt = MM[t], mt = BB[t] + Mt;
    bf16x8 sb[4], qb[4];
    {
        f32x4 sT[8];
#pragma unroll
        for (int st = 0; st < 8; ++st) { f32x4 a = {0.f, 0.f, 0.f, 0.f};
#pragma unroll
            for (int ks = 0; ks < 4; ++ks) a = MFMA16(kf[st][ks], qf[ks], a);
#pragma unroll
            for (int r = 0; r < 4; ++r) { const int s = 16 * st + 4 * quad + r; a[r] = (s <= t) ? a[r] * fast_exp(UU[s] - Mt) : 0.f; }
            sT[st] = a; }
#pragma unroll
        for (int kp = 0; kp < 4; ++kp) { const f32x4 p0 = sT[2 * kp], p1 = sT[2 * kp + 1];
            sb[kp] = mk_frag(pg8::cvt_pk_bf16(p0[0], p0[1]), pg8::cvt_pk_bf16(p0[2], p0[3]), pg8::cvt_pk_bf16(p1[0], p1[1]), pg8::cvt_pk_bf16(p1[2], p1[3])); }
        const float wi = fast_exp(mprev - Mt);
#pragma unroll
        for (int ks = 0; ks < 4; ++ks) { const v4u q = __builtin_bit_cast(v4u, qf[ks]);
            qb[ks] = mk_frag(pg8::cvt_pk_bf16(bf2f(q.x & 0xffffu) * wi, bf2f(q.x >> 16) * wi), pg8::cvt_pk_bf16(bf2f(q.y & 0xffffu) * wi, bf2f(q.y >> 16) * wi),
                             pg8::cvt_pk_bf16(bf2f(q.z & 0xffffu) * wi, bf2f(q.z >> 16) * wi), pg8::cvt_pk_bf16(bf2f(q.w & 0xffffu) * wi, bf2f(q.w >> 16) * wi)); }
    }
    const bf16* op = PROJ + grow * NPROJ + C_MO + h * 256 + 8 * quad; const bf16* zp = PROJ + grow * NPROJ + C_MZ + h * 256 + 8 * quad;
    v4u og[8], zz[8];
#pragma unroll
    for (int P2 = 0; P2 < 8; ++P2) { og[P2] = ldg16(op + 32 * P2); zz[P2] = ldg16(zp + 32 * P2); }
    const LAS unsigned char* vb = V + (4 * quad + tq) * 544 + 16 * tp;
    const LAS unsigned char* cb = CP + (8 * (l15 >> 2) + (l15 & 3)) * 272 + 16 * quad;
    f32x4 num[16]; float den;
    {   f32x4 a = {0.f, 0.f, 0.f, 0.f};
        const LAS unsigned char* vd = V + (4 * quad + tq) * 544 + 512 + 8 * tp; const LAS unsigned char* cd = CP + (256 + l15) * 272 + 16 * quad;
#pragma unroll
        for (int kp = 0; kp < 4; ++kp) { const LAS unsigned char* p = vd + (32 * kp) * 544; a = MFMA16(tr_frag(p, p + 16 * 544), sb[kp], a); }
#pragma unroll
        for (int ks = 0; ks < 4; ++ks) a = MFMA16(ld_frag16(cd + 64 * ks), qb[ks], a);
        den = __shfl(a[0], l15); }
#pragma unroll
    for (int P2 = 0; P2 < 8; ++P2)
#pragma unroll
        for (int hf = 0; hf < 2; ++hf) { f32x4 a = {0.f, 0.f, 0.f, 0.f};
#pragma unroll
            for (int kp = 0; kp < 4; ++kp) { const LAS unsigned char* p = vb + (32 * kp) * 544 + 64 * P2 + 8 * hf; a = MFMA16(tr_frag(p, p + 16 * 544), sb[kp], a); }
            const LAS unsigned char* cp = cb + (32 * P2 + 4 * hf) * 272;
#pragma unroll
            for (int ks = 0; ks < 4; ++ks) a = MFMA16(ld_frag16(cp + 64 * ks), qb[ks], a);
            num[2 * P2 + hf] = a; }
    const float inv = 1.0f / fmaxf(fabsf(den), expf(-mt));
    float s = 0.f;
#pragma unroll
    for (int P2 = 0; P2 < 8; ++P2) { const v4u o = og[P2];
        f32x4& a = num[2 * P2]; f32x4& bq = num[2 * P2 + 1];
        a[0] *= inv * bf2f(o.x & 0xffffu); a[1] *= inv * bf2f(o.x >> 16); a[2] *= inv * bf2f(o.y & 0xffffu); a[3] *= inv * bf2f(o.y >> 16);
        bq[0] *= inv * bf2f(o.z & 0xffffu); bq[1] *= inv * bf2f(o.z >> 16); bq[2] *= inv * bf2f(o.w & 0xffffu); bq[3] *= inv * bf2f(o.w >> 16);
        s += (a[0] + a[1]) + (a[2] + a[3]) + (bq[0] + bq[1]) + (bq[2] + bq[3]); }
    const float mean = quad_sum(s) * (1.0f / 256.0f);
    float q2 = 0.f;
#pragma unroll
    for (int i = 0; i < 16; ++i) { num[i] = num[i] - mean; q2 += (num[i][0] * num[i][0] + num[i][1] * num[i][1]) + (num[i][2] * num[i][2] + num[i][3] * num[i][3]); }
    const float rstd = 1.0f / sqrtf(quad_sum(q2) * (1.0f / 256.0f) + HEAD_NORM_EPS);
    const float* ng = m_norm_g + h * 256 + 8 * quad; bf16* mp = MIX + grow * DM + 1536 + h * 256 + 8 * quad;
#pragma unroll
    for (int P2 = 0; P2 < 8; ++P2) {
        const f32x4 g0 = *(const GAS f32x4*)(ng + 32 * P2), g1 = *(const GAS f32x4*)(ng + 32 * P2 + 4);
        stg16(mp + 32 * P2, gate_pack(num[2 * P2] * g0, num[2 * P2 + 1] * g1, 8.f * rstd, zz[P2])); }
    __syncthreads();
}

__device__ __forceinline__ void ln_phase(Frame& F, float inject) {
    const float* x = in_ptr(F, 0); const float* ln_g = in_ptr(F, 12); const float* ln_b = in_ptr(F, 13); float* out = out_ptr(F); bf16* Y = WSP(bf16, WS_Y);
    const int gw = F.vcu * NWAVES + F.wave, NGW = F.G * NWAVES;
    for (int m = gw; m < MROWS; m += NGW) {
        const GAS f32x4* xr = (const GAS f32x4*)(x + (size_t)m * DM) + F.lane;
        const GAS v2u* yr = (const GAS v2u*)(Y + (size_t)m * DM) + F.lane;
        f32x4 v[16]; float s = 0.f;
#pragma unroll
        for (int j = 0; j < 16; ++j) { const f32x4 xv = __builtin_nontemporal_load(xr + 64 * j); const v2u yv = yr[64 * j];
            v[j].x = DEEPNORM_ALPHA * xv.x + bf2f(yv.x & 0xffffu); v[j].y = DEEPNORM_ALPHA * xv.y + bf2f(yv.x >> 16);
            v[j].z = DEEPNORM_ALPHA * xv.z + bf2f(yv.y & 0xffffu); v[j].w = DEEPNORM_ALPHA * xv.w + bf2f(yv.y >> 16);
            s += (v[j].x + v[j].y) + (v[j].z + v[j].w); }
        const float mean = wave_sum(s) * (1.0f / DM); float s2 = 0.f;
#pragma unroll
        for (int j = 0; j < 16; ++j) { v[j] = v[j] - mean; s2 += (v[j].x * v[j].x + v[j].y * v[j].y) + (v[j].z * v[j].z + v[j].w * v[j].w); }
        const float rstd = 1.0f / sqrtf(wave_sum(s2) * (1.0f / DM) + LN_EPS);
        GAS f32x4* orow = (GAS f32x4*)(out + (size_t)m * DM) + F.lane;
        const GAS f32x4* gr = (const GAS f32x4*)ln_g + F.lane; const GAS f32x4* br = (const GAS f32x4*)ln_b + F.lane;
        const float inj = (m == gw) ? inject : 0.f;
#pragma unroll
        for (int j = 0; j < 16; ++j) __builtin_nontemporal_store(v[j] * rstd * gr[64 * j] + br[64 * j] + inj, orow + 64 * j);
    }
}

#ifndef MK_N_LAUNCHES
#define MK_N_LAUNCHES 1
#endif
constexpr int N_PHASES = 4;
struct Args { const float* in[14]; float* out; unsigned char* ws; int ph_lo, ph_hi; };
__global__ void __launch_bounds__(NWAVES * 64, 2) hymba_fwd(Args args) {
    extern __shared__ __attribute__((aligned(16))) unsigned char lds[];
    Frame F;
    F.lds = (LAS unsigned char*)lds;
    F.MISC = (volatile LAS unsigned*)(F.lds + MISC_OFF);
    F.tid = threadIdx.x; F.lane = F.tid & 63; F.wave = __builtin_amdgcn_readfirstlane(F.tid >> 6);
    F.G = gridDim.x; { const int bx = blockIdx.x; F.vcu = (F.G % 8 == 0) ? (bx % 8) * (F.G / 8) + bx / 8 : bx; }
    F.ws = args.ws; F.ctl = (gu32*)(args.ws + WS_CTL); F.kargs = (const CAS unsigned char*)__builtin_amdgcn_kernarg_segment_ptr();
    if (F.tid < 64) ((LAS unsigned*)(F.lds + MISC_OFF))[F.tid] = 0u;
    __syncthreads();
    const int lo = args.ph_lo, hi = args.ph_hi;
#ifdef PROBE_A
#define STAMP(k) do { __syncthreads(); if (F.tid == 0) F.MISC[20 + (k)] = (unsigned)__builtin_amdgcn_s_memrealtime(); __syncthreads(); } while (0)
#else
#define STAMP(k) do { } while (0)
#endif
    STAMP(0);
    XcdBarrier bar; bar.bar = (unsigned*)(F.ctl + CW_BAR); bar.x = 0; bar.st = nullptr; bar.wave = F.wave;
    if (hi - lo > 1) bar = xcd_barrier_post((unsigned*)(F.ctl + CW_BAR), F.MISC + 8, F.wave);
#ifdef ONLY_PHASE
#define IN(k) ((k) == ONLY_PHASE)
#else
#define IN(k) (lo <= (k) && (k) < hi)
#endif
#define BOTH(k) (IN(k) && IN((k) + 1))
    if (IN(0)) { p0_prologue(F); STAMP(10); if (BOTH(0)) xcd_barrier(bar); }
    STAMP(1);
    if (IN(1)) {
        gu32* early = F.ctl + CW_EARLY; gu32* qhead = F.ctl + CW_QHEAD;
        {   pg8::Gemm g{F.ws, (unsigned)WS_ACAT, (unsigned)WS_BTCAT, MROWS + MEMROWS, NPROJ + 2048, DM, (unsigned)WS_A8, 32, OPITCH}; pg8::InProjOrder S; S.G = F.G; S.c = (int)blockIdx.x; S.early = (unsigned*)early;
            pg8::EpiProj E{WSP(bf16, WS_PROJ), NPROJ, WSP(bf16, WS_MKV), 2048};
            pg8::gemm_phase<pg8::EpiProj, pg8::InProjOrder, false, true>(F.lds, g, S, E, F.wave); }
        F.lane = pg8::lane_now(); F.tid = F.wave * 64 + F.lane;
        STAMP(2);
        constexpr int Q_W = 128, Q_CLOC = Q_W + 256, Q_SWA1 = Q_CLOC + 64, Q_SCAN = Q_SWA1 + 65, Q_SWA2 = Q_SCAN + 192, Q_CROSS = Q_SWA2 + 256, Q_MOUT = Q_CROSS + 256, Q_END = Q_MOUT;
        int acq = 0;
        for (;;) {
            if (F.tid == 0) F.MISC[16] = __hip_atomic_fetch_add(qhead, 1u, RLX_AGENT);
            __syncthreads();
            const int q = (int)F.MISC[16];
            __syncthreads();
            if (q >= Q_END) break;
            const int need = q < Q_W ? 0 : (q < Q_SWA1 ? 1 : (q < Q_SCAN ? 2 : (q < Q_CROSS ? 1 : 3)));
            if (acq < need) { if (need == 3) STAMP(14); if (need == 2) STAMP(16);
                if (F.tid == 0) {
                    gu32* w = need == 1 ? early : (need == 2 ? F.ctl + CW_CLOCDONE : F.ctl + CW_SCANDONE);
                    const unsigned want = need == 1 ? (unsigned)F.G * NWAVES : (need == 2 ? 256u : 65u); unsigned sp = 0;
                    while (__hip_atomic_load(w, RLX_AGENT) < want) { __builtin_amdgcn_s_sleep(4); if (++sp > (1u << 23)) break; }
                    if (need == 3) while (__hip_atomic_load(F.ctl + CW_LATE, RLX_AGENT) < (unsigned)F.G * NWAVES) { __builtin_amdgcn_s_sleep(4); if (++sp > (1u << 23)) break; }
                    __builtin_amdgcn_fence(__ATOMIC_ACQUIRE, "agent"); asm volatile("s_waitcnt vmcnt(0)" ::: "memory"); }
                __syncthreads();
                acq = need;
                if (need == 1) STAMP(3); if (need == 3) STAMP(15); if (need == 2) STAMP(17);
            }
            if (q < Q_W) wout_item(F, q);
            else if (q < Q_CLOC) cloc_item3(F, q - Q_W);
            else if (q < Q_SWA1) swa_item4(F, q - Q_CLOC);
            else if (q < Q_SCAN) scan_item(F, q - Q_SWA1);
            else if (q < Q_SWA2) swa_item4(F, q - Q_SCAN + 64);
            else if (q < Q_CROSS) cross_item3(F, q - Q_SWA2);
            else mout_item3(F, q - Q_CROSS);
        }
        STAMP(4);
        if (BOTH(1)) xcd_barrier(bar);
    }
    STAMP(5); STAMP(6); STAMP(7);
    if (IN(2)) {
        pg8::Gemm g{F.ws, (unsigned)WS_MIX, (unsigned)WS_WOT, MROWS, DM, DM, (unsigned)WS_MIX, 40, (unsigned)(DM * 2)}; pg8::StaticOrder S; S.init(MROWS, DM, F.G, (int)blockIdx.x, 1);
        pg8::EpiY E{WSP(bf16, WS_Y), DM};
        pg8::gemm_phase<pg8::EpiY, pg8::StaticOrder, false, true, 24>(F.lds, g, S, E, F.wave);
        F.lane = pg8::lane_now(); F.tid = F.wave * 64 + F.lane;
        STAMP(13);
        if (BOTH(2)) xcd_barrier(bar);
    }
    STAMP(8);
    float inject = 0.f;
#ifdef PROBE_A
    STAMP(9);
    if ((int)blockIdx.x == PROBE_BLK) { const unsigned dt = F.MISC[20 + PROBE_B] - F.MISC[20 + PROBE_A]; inject = sqrtf(5.12e-3f * ((float)dt * 0.01f) / (float)(PROBE_FULL)); }
#endif
    if (IN(3)) ln_phase(F, inject);
#undef IN
#undef BOTH
}

extern "C" void kernel_launch(void* const* d_in, const int* in_sizes, int n_in, void* d_out, int out_size, void* d_ws, size_t ws_size, hipStream_t stream) {
    static int grid = 0;
    if (grid == 0) {
        if (n_in != 14 || in_sizes[0] != MROWS * DM || out_size != MROWS * DM || ws_size < WS_END) { fprintf(stderr, "kernel_launch: unexpected shapes (n_in %d, in0 %d, out %d, ws %zu); nothing launched\n", n_in, n_in > 0 ? in_sizes[0] : -1, out_size, ws_size); grid = -1; return; }
        int dev = 0, cus = 0, per_cu = 0;
        if (hipGetDevice(&dev) != hipSuccess || hipDeviceGetAttribute(&cus, hipDeviceAttributeMultiprocessorCount, dev) != hipSuccess) { grid = -1; return; }
        if (hipFuncSetAttribute((const void*)hymba_fwd, hipFuncAttributeMaxDynamicSharedMemorySize, LDS_BYTES) != hipSuccess) { fprintf(stderr, "kernel_launch: hipFuncSetAttribute failed\n"); grid = -1; return; }
        if (hipOccupancyMaxActiveBlocksPerMultiprocessor(&per_cu, (const void*)hymba_fwd, NWAVES * 64, LDS_BYTES) != hipSuccess || per_cu < 1) { fprintf(stderr, "kernel_launch: occupancy query says %d blocks per CU; nothing launched\n", per_cu); (void)hipGetLastError(); grid = -1; return; }
        if (cus != 256) { fprintf(stderr, "kernel_launch: the in-projection unit order is laid out for 256 CUs, found %d; nothing launched\n", cus); grid = -1; return; }
        grid = cus;
    }
    if (grid < 0) return;
    (void)hipMemsetAsync((char*)d_ws + WS_CTL, 0, CTL_ZERO_BYTES, stream);
    Args a{};
    for (int i = 0; i < 14; ++i) a.in[i] = (const float*)d_in[i];
    a.out = (float*)d_out; a.ws = (unsigned char*)d_ws;
#if MK_N_LAUNCHES == 1
    a.ph_lo = 0; a.ph_hi = N_PHASES;
    void* kargs[] = {&a};
    const hipError_t le = hipLaunchCooperativeKernel((const void*)hymba_fwd, dim3(grid), dim3(NWAVES * 64), kargs, LDS_BYTES, stream);
    if (le != hipSuccess) fprintf(stderr, "kernel_launch: cooperative launch failed: %s (grid %d)\n", hipGetErrorString(le), grid);
#ifdef PROBE_EXTRA
    a.ph_lo = PROBE_EXTRA; a.ph_hi = PROBE_EXTRA + 1; hipLaunchKernelGGL(hymba_fwd, dim3(grid), dim3(NWAVES * 64), LDS_BYTES, stream, a);
#endif
#else
    for (int p = 0; p < N_PHASES; ++p) { a.ph_lo = p; a.ph_hi = p + 1; hipLaunchKernelGGL(hymba_fwd, dim3(grid), dim3(NWAVES * 64), LDS_BYTES, stream, a); }
#endif
}
```
